# Optimizing an MI355X kernel written in HIP

```python
import jax, jax.numpy as jnp
from jax import lax
import numpy as np

D_MODEL = 1024
BATCH = 8
SEQ = 4096
DEPTH = 4

D_MIX = D_MODEL
ATT_HEAD_DIM = 64
ATT_WIDTH = D_MIX // 4
ATT_HEADS = ATT_WIDTH // ATT_HEAD_DIM
DILATED_BRANCHES = ((128, 1), (512, 4), (2048, 16))
ATT_BLOCK = 128
POOL_WINDOWS = (2, 4, 8, 16)
POOL_WIDTH = D_MIX // 4
POOL_GROUP_DIM = POOL_WIDTH // len(POOL_WINDOWS)
MLSTM_WIDTH = D_MIX - ATT_WIDTH - POOL_WIDTH
MLSTM_HEADS = 4
MLSTM_HEAD_DIM = MLSTM_WIDTH // MLSTM_HEADS
MLSTM_CONV = 4
MLSTM_CHUNK = 64
IN_WIDTH = 3 * ATT_WIDTH + POOL_WIDTH + 2 * MLSTM_WIDTH + 2 * MLSTM_HEADS
D_FF = ((8 * D_MODEL // 3 + 255) // 256) * 256
MACARON_WEIGHT = 0.5
EPS = 1e-6
NEG = -1e30

kernel_name = "hybrid_dilated_pool_mlstm_macaron"


def rmsnorm(x, w):
    xf = x.astype(jnp.float32)
    y = xf * lax.rsqrt(jnp.mean(xf * xf, axis=-1, keepdims=True) + EPS)
    return (y * w.astype(jnp.float32)).astype(x.dtype)


def swiglu(u, w_up, w_down):
    g, v = jnp.split(u @ w_up, 2, axis=-1)
    return (jax.nn.silu(g) * v) @ w_down


def dilated_branch(q, k, v, window, dilation):
    B, H, S, Dh = q.shape
    Q = ATT_BLOCK
    span = window // dilation
    L = S // dilation
    nb = -(-L // Q)
    Lp = nb * Q

    def strided(t):
        t = t.reshape(B, H, L, dilation, Dh).transpose(0, 1, 3, 2, 4)
        return jnp.pad(t, ((0, 0), (0, 0), (0, 0), (0, Lp - L), (0, 0)))

    def key_blocks(t):
        t = jnp.pad(t, ((0, 0), (0, 0), (0, 0), (Q, 0), (0, 0))).reshape(B, H, dilation, nb + 1, Q, Dh)
        return jnp.concatenate([t[:, :, :, :-1], t[:, :, :, 1:]], axis=4)

    qb = strided(q).reshape(B, H, dilation, nb, Q, Dh)
    kb = key_blocks(strided(k))
    vb = key_blocks(strided(v))
    qi = jnp.arange(nb)[:, None, None] * Q + jnp.arange(Q)[None, :, None]
    ki = jnp.arange(nb)[:, None, None] * Q - Q + jnp.arange(2 * Q)[None, None, :]
    dist = qi - ki
    mask = (dist >= 0) & (dist <= span) & (ki >= 0)
    s = jnp.einsum('bhrnqd,bhrnkd->bhrnqk', qb, kb) * (Dh ** -0.5)
    s = jnp.where(mask, s, NEG)
    m = jnp.max(s, axis=-1)
    p = jnp.exp(s - m[..., None])
    l = jnp.sum(p, axis=-1)
    o = jnp.einsum('bhrnqk,bhrnkd->bhrnqd', p, vb) / l[..., None]

    def unstrided(t):
        tail = t.shape[5:]
        t = t.reshape((B, H, dilation, Lp) + tail)[:, :, :, :L]
        t = jnp.moveaxis(t, 2, 3)
        return t.reshape((B, H, S) + tail)

    return unstrided(o), unstrided(m), unstrided(l)


def dilated_attention(q, k, v):
    q, k, v = (t.astype(jnp.float32) for t in (q, k, v))
    outs = [dilated_branch(q, k, v, w, d) for (w, d) in DILATED_BRANCHES]
    o_all = jnp.stack([o for o, _, _ in outs])
    m_all = jnp.stack([m for _, m, _ in outs])
    l_all = jnp.stack([l for _, _, l in outs])
    wts = l_all * jnp.exp(m_all - jnp.max(m_all, axis=0, keepdims=True))
    wts = wts / jnp.sum(wts, axis=0, keepdims=True)
    return jnp.sum(wts[..., None] * o_all, axis=0)


def pool_mixer(p, pool_w, pool_scale):
    B, S, C = p.shape
    G = POOL_GROUP_DIM
    pf = p.astype(jnp.float32)
    cs = jnp.cumsum(pf, axis=1)
    count = jnp.arange(1, S + 1, dtype=jnp.float32)[None, :, None]
    outs = []
    for g, w in enumerate(POOL_WINDOWS):
        c_g = cs[:, :, g * G:(g + 1) * G]
        lag = jnp.pad(c_g[:, :S - w], ((0, 0), (w, 0), (0, 0)))
        outs.append((c_g - lag) / jnp.minimum(count, w) - pf[:, :, g * G:(g + 1) * G])
    d = jnp.stack(outs, axis=2)
    y = jnp.einsum('bsgc,gce->bsge', d, pool_w.astype(jnp.float32)).reshape(B, S, C)
    return (y * pool_scale).astype(p.dtype)


def causal_conv(x, w, b):
    K = w.shape[0]
    S = x.shape[1]
    xp = jnp.pad(x, ((0, 0), (K - 1, 0), (0, 0)))
    y = xp[:, 0:S] * w[0]
    for t in range(1, K):
        y = y + xp[:, t:t + S] * w[t]
    return y + b


def mlstm_chunkwise(q, k, v, i_pre, f_pre):
    B, H, S, dh = q.shape
    L = MLSTM_CHUNK
    NC = S // L
    qc = q.astype(jnp.float32).reshape(B, H, NC, L, dh) * (dh ** -0.5)
    kc = k.astype(jnp.float32).reshape(B, H, NC, L, dh)
    vc = v.astype(jnp.float32).reshape(B, H, NC, L, dh)
    ic = i_pre.astype(jnp.float32).reshape(B, H, NC, L)
    logf = jax.nn.log_sigmoid(f_pre.astype(jnp.float32)).reshape(B, H, NC, L)
    b = jnp.cumsum(logf, axis=-1)
    b_last = b[..., -1]
    causal = jnp.tril(jnp.ones((L, L), dtype=bool))
    logD = jnp.where(causal, b[..., :, None] - b[..., None, :] + ic[..., None, :], NEG)
    a = b_last[..., None] - b + ic
    a_max = jnp.max(a, axis=-1)
    wa = jnp.exp(a - a_max[..., None])
    dC = jnp.einsum('bhcl,bhcld,bhcle->bhcde', wa, kc, vc)
    dn = jnp.einsum('bhcl,bhcld->bhcd', wa, kc)

    def step(carry, xs):
        C, n, m = carry
        bl, am, dC_c, dn_c = xs
        m_new = jnp.maximum(bl + m, am)
        decay = jnp.exp(bl + m - m_new)
        inj = jnp.exp(am - m_new)
        C_new = decay[..., None, None] * C + inj[..., None, None] * dC_c
        n_new = decay[..., None] * n + inj[..., None] * dn_c
        return (C_new, n_new, m_new), (C, n, m)

    init = (jnp.zeros((B, H, dh, dh), jnp.float32), jnp.zeros((B, H, dh), jnp.float32),
            jnp.zeros((B, H), jnp.float32))
    xs = (jnp.moveaxis(b_last, 2, 0), jnp.moveaxis(a_max, 2, 0), jnp.moveaxis(dC, 2, 0), jnp.moveaxis(dn, 2, 0))
    _, (C_prev, n_prev, m_prev) = lax.scan(step, init, xs)
    C_prev = jnp.moveaxis(C_prev, 0, 2)
    n_prev = jnp.moveaxis(n_prev, 0, 2)
    m_prev = jnp.moveaxis(m_prev, 0, 2)
    inter_log = b + m_prev[..., None]
    m_t = jnp.maximum(inter_log, jnp.max(logD, axis=-1))
    inter_w = jnp.exp(inter_log - m_t)
    sw = jnp.einsum('bhcld,bhcsd->bhcls', qc, kc) * jnp.exp(logD - m_t[..., None])
    num = inter_w[..., None] * jnp.einsum('bhcld,bhcde->bhcle', qc, C_prev) + jnp.einsum('bhcls,bhcse->bhcle', sw, vc)
    den = inter_w * jnp.einsum('bhcld,bhcd->bhcl', qc, n_prev) + jnp.sum(sw, axis=-1)
    h = num / jnp.maximum(jnp.abs(den), jnp.exp(-m_t))[..., None]
    return h.reshape(B, H, S, dh)


def hybrid_mixer(u, w_in, w_out, pool_w, pool_scale, conv_w, conv_b, qkv_w, gate_b, norm_w, skip):
    B, S, _ = u.shape
    widths = [ATT_WIDTH, ATT_WIDTH, ATT_WIDTH, POOL_WIDTH, MLSTM_WIDTH, MLSTM_WIDTH, MLSTM_HEADS, MLSTM_HEADS]
    idx = []
    acc = 0
    for wd in widths[:-1]:
        acc += wd
        idx.append(acc)
    aq, ak, av, p_in, xm, og, ig, fg = jnp.split(u @ w_in, idx, axis=-1)

    def heads(t, n):
        return t.reshape(B, S, n, -1).transpose(0, 2, 1, 3)

    att = dilated_attention(heads(aq, ATT_HEADS), heads(ak, ATT_HEADS), heads(av, ATT_HEADS))
    att = att.transpose(0, 2, 1, 3).reshape(B, S, ATT_WIDTH).astype(u.dtype)
    pool = pool_mixer(p_in, pool_w, pool_scale)
    xc = jax.nn.silu(causal_conv(xm, conv_w, conv_b))
    xch = xc.reshape(B, S, MLSTM_HEADS, MLSTM_HEAD_DIM)
    xmh = xm.reshape(B, S, MLSTM_HEADS, MLSTM_HEAD_DIM)
    q = jnp.einsum('bshd,hde->bhse', xch, qkv_w[0])
    k = jnp.einsum('bshd,hde->bhse', xch, qkv_w[1])
    v = jnp.einsum('bshd,hde->bhse', xmh, qkv_w[2])
    i_pre = (ig + gate_b[0]).transpose(0, 2, 1)
    f_pre = (fg + gate_b[1]).transpose(0, 2, 1)
    h = mlstm_chunkwise(q, k, v, i_pre, f_pre)
    h = h * jax.nn.sigmoid(heads(og, MLSTM_HEADS).astype(jnp.float32))
    h = rmsnorm(h, norm_w.reshape(MLSTM_HEADS, 1, MLSTM_HEAD_DIM))
    h = h.transpose(0, 2, 1, 3).reshape(B, S, MLSTM_WIDTH).astype(u.dtype) + skip * xc
    mixed = jnp.concatenate([att, pool, h], axis=-1)
    return mixed @ w_out


def sublayer(h, mod_j, pre_w, post_w, fn, weight):
    shift, scale, gate = mod_j[:, 0], mod_j[:, 1], mod_j[:, 2]
    u = rmsnorm(h, pre_w) * (1 + scale) + shift
    return h + weight * gate * rmsnorm(fn(u), post_w)


def setup_inputs(seed: int = 0) -> dict:
    key = jax.random.key(seed)
    ks = jax.random.split(key, 20)

    def nrm(k, shape, s):
        return jax.random.normal(k, shape, jnp.float32) * s

    x = nrm(ks[0], (BATCH, SEQ, D_MODEL), 1.0)
    c = nrm(ks[1], (BATCH, D_MODEL), 1.0)
    ada_w = nrm(ks[2], (DEPTH, D_MODEL, 9 * D_MODEL), D_MODEL ** -0.5)
    ada_b = nrm(ks[3], (DEPTH, 9 * D_MODEL), 0.02)
    pre_norm_w = 1.0 + nrm(ks[4], (DEPTH, 3, D_MODEL), 0.05)
    post_norm_w = 1.0 + nrm(ks[5], (DEPTH, 3, D_MODEL), 0.05)
    ffn_up = nrm(ks[6], (DEPTH, 2, D_MODEL, 2 * D_FF), D_MODEL ** -0.5)
    ffn_down = nrm(ks[7], (DEPTH, 2, D_FF, D_MODEL), D_FF ** -0.5)
    mix_in_w = nrm(ks[8], (DEPTH, D_MODEL, IN_WIDTH), D_MODEL ** -0.5)
    mix_out_w = nrm(ks[9], (DEPTH, D_MIX, D_MODEL), D_MIX ** -0.5)
    pool_w = nrm(ks[10], (DEPTH, len(POOL_WINDOWS), POOL_GROUP_DIM, POOL_GROUP_DIM), POOL_GROUP_DIM ** -0.5)
    pool_scale = 1.0 + nrm(ks[11], (DEPTH, POOL_WIDTH), 0.1)
    mlstm_conv_w = nrm(ks[12], (DEPTH, MLSTM_CONV, MLSTM_WIDTH), MLSTM_CONV ** -0.5)
    mlstm_conv_b = nrm(ks[13], (DEPTH, MLSTM_WIDTH), 0.02)
    mlstm_qkv_w = nrm(ks[14], (DEPTH, 3, MLSTM_HEADS, MLSTM_HEAD_DIM, MLSTM_HEAD_DIM), MLSTM_HEAD_DIM ** -0.5)
    i_b = nrm(ks[15], (DEPTH, MLSTM_HEADS), 0.1)
    f_b = jnp.linspace(3.0, 6.0, MLSTM_HEADS, dtype=jnp.float32)[None, :] + nrm(ks[16], (DEPTH, MLSTM_HEADS), 0.1)
    mlstm_gate_b = jnp.stack([i_b, f_b], axis=1)
    mlstm_norm_w = 1.0 + nrm(ks[17], (DEPTH, MLSTM_WIDTH), 0.05)
    mlstm_skip = 1.0 + nrm(ks[18], (DEPTH, MLSTM_WIDTH), 0.1)
    return {"x": x, "c": c, "ada_w": ada_w, "ada_b": ada_b, "pre_norm_w": pre_norm_w,
            "post_norm_w": post_norm_w, "ffn_up": ffn_up, "ffn_down": ffn_down, "mix_in_w": mix_in_w,
            "mix_out_w": mix_out_w, "pool_w": pool_w, "pool_scale": pool_scale,
            "mlstm_conv_w": mlstm_conv_w, "mlstm_conv_b": mlstm_conv_b, "mlstm_qkv_w": mlstm_qkv_w,
            "mlstm_gate_b": mlstm_gate_b, "mlstm_norm_w": mlstm_norm_w, "mlstm_skip": mlstm_skip}


def reference(x, c, ada_w, ada_b, pre_norm_w, post_norm_w, ffn_up, ffn_down, mix_in_w, mix_out_w,
              pool_w, pool_scale, mlstm_conv_w, mlstm_conv_b, mlstm_qkv_w, mlstm_gate_b, mlstm_norm_w,
              mlstm_skip):
    B = x.shape[0]
    c_act = jax.nn.silu(c)
    h = x
    for l in range(DEPTH):
        mod = (c_act @ ada_w[l] + ada_b[l]).reshape(B, 3, 3, 1, D_MODEL)
        h = sublayer(h, mod[:, 0], pre_norm_w[l, 0], post_norm_w[l, 0],
                     lambda u: swiglu(u, ffn_up[l, 0], ffn_down[l, 0]), MACARON_WEIGHT)
        h = sublayer(h, mod[:, 1], pre_norm_w[l, 1], post_norm_w[l, 1],
                     lambda u: hybrid_mixer(u, mix_in_w[l], mix_out_w[l], pool_w[l], pool_scale[l],
                                            mlstm_conv_w[l], mlstm_conv_b[l], mlstm_qkv_w[l],
                                            mlstm_gate_b[l], mlstm_norm_w[l], mlstm_skip[l]), 1.0)
        h = sublayer(h, mod[:, 2], pre_norm_w[l, 2], post_norm_w[l, 2],
                     lambda u: swiglu(u, ffn_up[l, 1], ffn_down[l, 1]), MACARON_WEIGHT)
    return h
```

```cpp
#ifndef EMU
#include <hip/hip_runtime.h>
#include <cstdio>
#include <cstdint>
#define DEV __device__ __forceinline__
#define LAS __attribute__((address_space(3)))
#define WAVE_LDS_SYNC() asm volatile("s_waitcnt lgkmcnt(0)" ::: "memory")
#define NT_LOAD(T, p) __builtin_nontemporal_load((const T*)(p))
#define NT_STORE(T, p, v) __builtin_nontemporal_store((v), (T*)(p))
#define SCHED_FENCE() __builtin_amdgcn_sched_barrier(0)
DEV unsigned f2bf(float f) { unsigned u = __builtin_bit_cast(unsigned, f); return (u + 0x7fffu + ((u >> 16) & 1u)) >> 16; }
typedef float mk_f32x2 __attribute__((ext_vector_type(2)));
typedef __bf16 mk_bf16x2 __attribute__((ext_vector_type(2)));
DEV unsigned pk2(float lo, float hi) { const mk_f32x2 v = {lo, hi}; return __builtin_bit_cast(unsigned, __builtin_convertvector(v, mk_bf16x2)); }
DEV int lnd(int x) { asm volatile("" : "+v"(x)); return x; }
DEV unsigned char* lndp(unsigned char* p) { size_t z = 0; asm volatile("" : "+s"(z)); return p + z; }
DEV int mk_lane_id() { unsigned z = 0u; asm volatile("" : "+s"(z)); return (int)__builtin_amdgcn_mbcnt_hi(~0u, __builtin_amdgcn_mbcnt_lo(~0u, z)); }
DEV bool any_lane(bool p) { return __builtin_amdgcn_ballot_w64(p) != 0ull; }
typedef unsigned mk_u32x2 __attribute__((ext_vector_type(2)));
DEV void st_wt8(void* p, mk_u32x2 v) { __hip_atomic_store((unsigned long long*)p, __builtin_bit_cast(unsigned long long, v), __ATOMIC_RELAXED, __HIP_MEMORY_SCOPE_AGENT); }
DEV void publish_rows(unsigned* cnt, int lane) { asm volatile("s_waitcnt vmcnt(0)" ::: "memory"); if (lane == 0) __hip_atomic_fetch_add(cnt, 1u, __ATOMIC_RELAXED, __HIP_MEMORY_SCOPE_AGENT); }
DEV int rfl(int x) { return __builtin_amdgcn_readfirstlane(x); }
DEV float fast_exp2(float x) { return __builtin_amdgcn_exp2f(x); }
DEV float fast_rcp(float x) { return __builtin_amdgcn_rcpf(x); }
DEV unsigned pk_fp8x4(float a, float b, float c, float d) {
    a = __builtin_amdgcn_fmed3f(a, -448.f, 448.f); b = __builtin_amdgcn_fmed3f(b, -448.f, 448.f); c = __builtin_amdgcn_fmed3f(c, -448.f, 448.f); d = __builtin_amdgcn_fmed3f(d, -448.f, 448.f);
    int w = 0; w = __builtin_amdgcn_cvt_pk_fp8_f32(a, b, w, false); w = __builtin_amdgcn_cvt_pk_fp8_f32(c, d, w, true); return (unsigned)w; }
DEV unsigned pk_i8x4(float a, float b, float c, float d) { const int ia = (int)__builtin_rintf(a), ib = (int)__builtin_rintf(b), ic = (int)__builtin_rintf(c), id = (int)__builtin_rintf(d);
    return (unsigned)(ia & 255) | ((unsigned)(ib & 255) << 8) | ((unsigned)(ic & 255) << 16) | ((unsigned)id << 24); }
DEV unsigned pk_i8x4s(float a, float b, float c, float d, float inv) { const float MG = 12582912.0f;
    const unsigned ua = __builtin_bit_cast(unsigned, __builtin_fmaf(a, inv, MG)), ub = __builtin_bit_cast(unsigned, __builtin_fmaf(b, inv, MG)), uc = __builtin_bit_cast(unsigned, __builtin_fmaf(c, inv, MG)), ud = __builtin_bit_cast(unsigned, __builtin_fmaf(d, inv, MG));
    return __builtin_amdgcn_perm(ub, ua, 0x0c0c0400u) | __builtin_amdgcn_perm(ud, uc, 0x04000c0cu); }
typedef short mk_bf16x8 __attribute__((ext_vector_type(8)));
typedef float mk_f32x4 __attribute__((ext_vector_type(4)));
DEV mk_f32x4 mfma16(mk_bf16x8 a, mk_bf16x8 b, mk_f32x4 c) { return __builtin_amdgcn_mfma_f32_16x16x32_bf16(a, b, c, 0, 0, 0); }
#endif
#ifndef MK_F8MASK
#define MK_F8MASK 0xF8
#endif
#ifndef MK_I8MASK
#define MK_I8MASK 0xFF
#endif
#ifndef MK_HIDPAD
#define MK_HIDPAD 0
#endif
#define HID_PITCH8 (2816 + MK_HIDPAD)
#define HID_PITCH16 (2816 + MK_HIDPAD / 2)
#ifndef MK_I8IN
#define MK_I8IN 0
#endif
#define F8_SH 4.0f
#define UPW_GATE (-1.4426950408889634f)
#define UPW_VAL (-0.6931471805599453f)
#define F8_SW 512.0f
#define U8_BSTRIDE ((size_t)4096 * 2048)
DEV size_t u8_row(int row) { return (size_t)(row >> 12) * U8_BSTRIDE + (size_t)(row & 4095) * 1024; }
DEV size_t u8_rs(int row) { return (size_t)(row >> 12) * U8_BSTRIDE + (size_t)4096 * 1024 + (size_t)(row & 4095) * 4; }
#ifndef MK_MULTI
#define MK_MULTI 0
#endif
#ifndef EMU
#ifndef MK_WGM
#define MK_WGM 4
#endif
namespace pg8 {
#define PG8_LAS __attribute__((address_space(3)))
typedef unsigned short bf16_t;
typedef short bf16x8 __attribute__((ext_vector_type(8)));
typedef float f32x4 __attribute__((ext_vector_type(4)));
typedef int i32x8 __attribute__((ext_vector_type(8)));
typedef int i32x4 __attribute__((ext_vector_type(4)));
typedef unsigned u32x4 __attribute__((ext_vector_type(4)));
constexpr int BM = 256, BK = 64, HALF = 128, HTB = HALF * BK * 2  , STAGE_BYTES = 8 * HTB, NXCD = 8, WGM = MK_WGM;

__host__ __device__ __forceinline__ int lds_byte(int r, int c) { const int st = (r >> 4) * 2 + (c >> 5), rr = r & 15, cc = c & 31, ob = rr * 64 + cc * 2; return st * 1024 + (ob ^ (((ob >> 9) & 1) << 5)); }
__host__ __device__ __forceinline__ void stage_rc(int b, int& R, int& C) { const int st = b / 1024, sb = b % 1024, swz = sb ^ (((sb >> 9) & 1) << 5); R = (st >> 1) * 16 + swz / 64; C = (st & 1) * 32 + (swz % 64) / 2; }
__host__ __device__ __forceinline__ int perm32(int rho) { const int n = rho >> 4, i = rho & 15; return 8 * (i >> 2) + 4 * n + (i & 3); }

struct Unit { int pm, pn; };
struct Gemm { const bf16_t* A; const bf16_t* Bt; int M, N, K; bool f8 = false; size_t a_bgap = 0; int lda = 0; };

struct StaticOrder {
    int nM, nN, nwg, G, c, rev = 0;
    __host__ __device__ void init(int M, int N, int G_, int c_) { nM = M / BM; nN = N / BM; nwg = nM * nN; G = G_; c = c_; }
    __host__ __device__ bool next(int i, Unit& u) const {
        const long L = (long)i * G + c; if (L >= nwg) return false;
        int wgid = (int)L; { const int q = nwg / NXCD, r = nwg % NXCD, xcd = wgid % NXCD, off = wgid / NXCD; wgid = (xcd < r ? xcd * (q + 1) : r * (q + 1) + (xcd - r) * q) + off; }
        const int nig = WGM * nN, gid = wgid / nig, fm = gid * WGM, gsz = (nM - fm) < WGM ? (nM - fm) : WGM;
        u.pm = fm + ((wgid % nig) % gsz); u.pn = (wgid % nig) / gsz; if (rev) u.pm ^= 15;
        return true;
    }
    __device__ __forceinline__ void a_ready(const Unit&) const {}
    __device__ __forceinline__ void done(const Unit&) const {}
};

__device__ __forceinline__ unsigned cvt_pk_bf16(float lo, float hi) { return ::pk2(lo, hi); }
typedef float f32x2 __attribute__((ext_vector_type(2)));
typedef unsigned u32x2 __attribute__((ext_vector_type(2)));
__device__ __forceinline__ float silu_f(float g) { return g * __builtin_amdgcn_rcpf(1.0f + __expf(-g)); }
struct EpiSwiglu {
    static constexpr bool PERM = true, AFTER_DRAIN = false;
    bf16_t* H; int ldh;
    __device__ __forceinline__ void operator()(const f32x4 (&acc)[2][2][4][2], const Unit& u, int wr, int wc, int fr, int fq) const {
        const int row0 = u.pm * BM + wr * 64 + fr, col0 = u.pn * HALF + wc * 32 + 8 * fq;
#pragma unroll
        for (int ai = 0; ai < 2; ++ai)
#pragma unroll
            for (int m = 0; m < 4; ++m) { bf16_t* rowp = H + (size_t)(row0 + ai * HALF + m * 16) * ldh + col0;
                const f32x4 g0 = acc[ai][0][m][0], g1 = acc[ai][0][m][1], v0 = acc[ai][1][m][0], v1 = acc[ai][1][m][1];
                u32x4 w; w.x = cvt_pk_bf16(silu_f(g0[0]) * v0[0], silu_f(g0[1]) * v0[1]); w.y = cvt_pk_bf16(silu_f(g0[2]) * v0[2], silu_f(g0[3]) * v0[3]);
                w.z = cvt_pk_bf16(silu_f(g1[0]) * v1[0], silu_f(g1[1]) * v1[1]); w.w = cvt_pk_bf16(silu_f(g1[2]) * v1[2], silu_f(g1[3]) * v1[3]);
                *(u32x4*)rowp = w; }
    }
};
__device__ __forceinline__ f32x2 swiglu2(float ga, float gb, float va, float vb) {
    const f32x2 g = {ga, gb}, v = {va, vb}; f32x2 d = {__builtin_amdgcn_exp2f(ga), __builtin_amdgcn_exp2f(gb)}; d = d + 1.0f;
    const f32x2 r = {__builtin_amdgcn_rcpf(d[0]), __builtin_amdgcn_rcpf(d[1])}; return (g * v) * r; }
struct EpiSwigluX {
    static constexpr bool PERM = true, AFTER_DRAIN = false;
    unsigned char* H; int ldh; bool f8;
    __device__ __forceinline__ void operator()(const f32x4 (&acc)[2][2][4][2], const Unit& u, int wr, int wc, int fr, int fq) const {
        const int row0 = u.pm * BM + wr * 64 + fr, col0 = u.pn * HALF + wc * 32 + 8 * fq;
        if (f8) {
#pragma unroll
            for (int ai = 0; ai < 2; ++ai)
#pragma unroll
                for (int m = 0; m < 4; ++m) { unsigned char* rowp = H + (size_t)(row0 + ai * HALF + m * 16) * ldh + col0;
                    const f32x4 g0 = acc[ai][0][m][0], g1 = acc[ai][0][m][1], v0 = acc[ai][1][m][0], v1 = acc[ai][1][m][1];
                    const f32x2 a = swiglu2(g0[0], g0[1], v0[0], v0[1]), b = swiglu2(g0[2], g0[3], v0[2], v0[3]), c = swiglu2(g1[0], g1[1], v1[0], v1[1]), d = swiglu2(g1[2], g1[3], v1[2], v1[3]);
                    u32x2 w; w.x = ::pk_fp8x4(a[0], a[1], b[0], b[1]); w.y = ::pk_fp8x4(c[0], c[1], d[0], d[1]);
                    *(u32x2*)rowp = w; }
        } else {
#pragma unroll
            for (int ai = 0; ai < 2; ++ai)
#pragma unroll
                for (int m = 0; m < 4; ++m) { bf16_t* rowp = (bf16_t*)H + (size_t)(row0 + ai * HALF + m * 16) * ldh + col0;
                    const f32x4 g0 = acc[ai][0][m][0], g1 = acc[ai][0][m][1], v0 = acc[ai][1][m][0], v1 = acc[ai][1][m][1];
                    const f32x2 a = swiglu2(g0[0], g0[1], v0[0], v0[1]), b = swiglu2(g0[2], g0[3], v0[2], v0[3]), c = swiglu2(g1[0], g1[1], v1[0], v1[1]), d = swiglu2(g1[2], g1[3], v1[2], v1[3]);
                    u32x4 w; w.x = cvt_pk_bf16(a[0], a[1]); w.y = cvt_pk_bf16(b[0], b[1]); w.z = cvt_pk_bf16(c[0], c[1]); w.w = cvt_pk_bf16(d[0], d[1]);
                    *(u32x4*)rowp = w; }
        }
    }
};
#ifndef MK_HID_NT
#define MK_HID_NT 0
#endif
#if MK_HID_NT
#define HID_STORE(T, p, v) __builtin_nontemporal_store((v), (T*)(p))
#else
#define HID_STORE(T, p, v) (*(T*)(p) = (v))
#endif
struct EpiSwigluI8 {
    static constexpr bool PERM = true, AFTER_DRAIN = false;
    unsigned char* H; int ldh; bool f8; const unsigned char* U8; const float* CS; int dff;
    __device__ __forceinline__ void operator()(const f32x4 (&acc)[2][2][4][2], const Unit& u, int wr, int wc, int fr, int fq) const {
        const int row0 = u.pm * BM + wr * 64 + fr, col0 = u.pn * HALF + wc * 32 + 8 * fq;
        const f32x4 cg0 = *(const f32x4*)(CS + col0), cg1 = *(const f32x4*)(CS + col0 + 4), cv0 = *(const f32x4*)(CS + dff + col0), cv1 = *(const f32x4*)(CS + dff + col0 + 4);
        float rsv[2][4];
#pragma unroll
        for (int ai = 0; ai < 2; ++ai)
#pragma unroll
            for (int m = 0; m < 4; ++m) rsv[ai][m] = *(const float*)(U8 + ::u8_rs(row0 + ai * HALF + m * 16));
#ifdef EPIREP
        for (int rep_ = 0; rep_ < EPIREP; ++rep_) { asm volatile("" ::: "memory");
#endif
#pragma unroll
        for (int ai = 0; ai < 2; ++ai)
#pragma unroll
            for (int m = 0; m < 4; ++m) { const size_t ro = (size_t)(row0 + ai * HALF + m * 16) * ldh + col0; const float rs = rsv[ai][m];
                const f32x4 g0 = __builtin_convertvector(__builtin_bit_cast(i32x4, acc[ai][0][m][0]), f32x4) * (cg0 * rs), g1 = __builtin_convertvector(__builtin_bit_cast(i32x4, acc[ai][0][m][1]), f32x4) * (cg1 * rs);
                const f32x4 v0 = __builtin_convertvector(__builtin_bit_cast(i32x4, acc[ai][1][m][0]), f32x4) * (cv0 * rs), v1 = __builtin_convertvector(__builtin_bit_cast(i32x4, acc[ai][1][m][1]), f32x4) * (cv1 * rs);
                const f32x2 a = swiglu2(g0[0], g0[1], v0[0], v0[1]), b = swiglu2(g0[2], g0[3], v0[2], v0[3]), c = swiglu2(g1[0], g1[1], v1[0], v1[1]), d = swiglu2(g1[2], g1[3], v1[2], v1[3]);
                if (f8) { u32x2 w; w.x = ::pk_fp8x4(a[0], a[1], b[0], b[1]); w.y = ::pk_fp8x4(c[0], c[1], d[0], d[1]); HID_STORE(u32x2, H + ro, w); }
                else { u32x4 w; w.x = cvt_pk_bf16(a[0], a[1]); w.y = cvt_pk_bf16(b[0], b[1]); w.z = cvt_pk_bf16(c[0], c[1]); w.w = cvt_pk_bf16(d[0], d[1]); HID_STORE(u32x4, (bf16_t*)H + ro, w); } }
#ifdef EPIREP
        }
#endif
    }
};
struct EpiY {
    static constexpr bool PERM = true, AFTER_DRAIN = false;
    bf16_t* O; int ldc;
    __device__ __forceinline__ void operator()(const f32x4 (&acc)[2][2][4][2], const Unit& u, int wr, int wc, int fr, int fq) const {
        const int row0 = u.pm * BM + wr * 64 + fr, col0 = u.pn * BM + wc * 32 + 8 * fq;
#pragma unroll
        for (int ai = 0; ai < 2; ++ai)
#pragma unroll
            for (int m = 0; m < 4; ++m) { bf16_t* rowp = O + (size_t)(row0 + ai * HALF + m * 16) * ldc + col0;
#pragma unroll
                for (int bj = 0; bj < 2; ++bj) { const f32x4 v0 = acc[ai][bj][m][0], v1 = acc[ai][bj][m][1];
                    u32x4 w; w.x = cvt_pk_bf16(v0[0], v0[1]); w.y = cvt_pk_bf16(v0[2], v0[3]); w.z = cvt_pk_bf16(v1[0], v1[1]); w.w = cvt_pk_bf16(v1[2], v1[3]);
                    *(u32x4*)(rowp + bj * HALF) = w; } }
    }
};
struct EpiMixIn {
    static constexpr bool PERM = false, AFTER_DRAIN = false;
    bf16_t *Q16, *K16, *VT16, *PIN, *XM, *OG;
    __device__ __forceinline__ void operator()(const f32x4 (&acc)[2][2][4][2], const Unit& u, int wr, int wc, int fr, int fq) const {
        const int pn = u.pn, rowb = u.pm * BM + wr * 64 + fr, tc0 = wc * 32 + 4 * fq;
        if (pn <= 1) {
            bf16_t* base = pn == 0 ? Q16 : K16; const float sc = pn == 0 ? 0.18033688011112042f : 1.0f;
#pragma unroll
            for (int ai = 0; ai < 2; ++ai)
#pragma unroll
                for (int m = 0; m < 4; ++m) { const int row = rowb + ai * HALF + m * 16, b = row >> 12, s = row & 4095, r = s & 15, j = s >> 4;
#pragma unroll
                    for (int bj = 0; bj < 2; ++bj)
#pragma unroll
                        for (int n = 0; n < 2; ++n) { const int tc = bj * HALF + n * 16 + tc0, hd = tc >> 6, d = tc & 63; const f32x4 v = acc[ai][bj][m][n] * sc;
                            u32x2 w; w.x = cvt_pk_bf16(v[0], v[1]); w.y = cvt_pk_bf16(v[2], v[3]);
                            *(u32x2*)(base + (((((size_t)(b * 4 + hd) * 16 + r) * 16 + (j >> 4)) * 1024) + (d >> 5) * 512 + (j & 15) * 32 + ((d >> 3) & 3) * 8 + (d & 7))) = w; } }
        } else if (pn == 2) {
            const int b = (u.pm * BM) >> 12, jb = ((u.pm * BM) & 4095) >> 4;
#pragma unroll
            for (int ai = 0; ai < 2; ++ai)
#pragma unroll
                for (int bj = 0; bj < 2; ++bj)
#pragma unroll
                    for (int n = 0; n < 2; ++n) { const int tc = bj * HALF + n * 16 + tc0, hd = tc >> 6, d = tc & 63;
#pragma unroll
                        for (int e = 0; e < 4; ++e) { u32x2 w; w.x = cvt_pk_bf16(acc[ai][bj][0][n][e], acc[ai][bj][1][n][e]); w.y = cvt_pk_bf16(acc[ai][bj][2][n][e], acc[ai][bj][3][n][e]);
                            *(u32x2*)(VT16 + (((((size_t)(b * 4 + hd) * 16 + fr) * 16 + (jb >> 4)) * 1024) + (d + e) * 16 + 8 * ai + 4 * wr)) = w; } }
        } else {
            bf16_t* base; int ld, c0;
            if (pn == 3) { base = PIN; ld = 256; c0 = 0; } else if (pn <= 5) { base = XM; ld = 512; c0 = (pn - 4) * 256; } else { base = OG; ld = 512; c0 = (pn - 6) * 256; }
#pragma unroll
            for (int ai = 0; ai < 2; ++ai)
#pragma unroll
                for (int m = 0; m < 4; ++m) { bf16_t* rowp = base + (size_t)(rowb + ai * HALF + m * 16) * ld + c0 + tc0;
#pragma unroll
                    for (int bj = 0; bj < 2; ++bj)
#pragma unroll
                        for (int n = 0; n < 2; ++n) { const f32x4 v = acc[ai][bj][m][n]; u32x2 w; w.x = cvt_pk_bf16(v[0], v[1]); w.y = cvt_pk_bf16(v[2], v[3]);
                            *(u32x2*)(rowp + bj * HALF + n * 16) = w; } }
        }
    }
};
struct EpiMixInI8 {
    static constexpr bool PERM = false, AFTER_DRAIN = false;
    EpiMixIn base; const unsigned char* U8; const float* CS;
    __device__ __forceinline__ void operator()(const f32x4 (&acc_)[2][2][4][2], const Unit& u, int wr, int wc, int fr, int fq) const {
        f32x4 (&acc)[2][2][4][2] = const_cast<f32x4 (&)[2][2][4][2]>(acc_);
        const int rowb = u.pm * BM + wr * 64 + fr, tc0 = u.pn * BM + wc * 32 + 4 * fq;
        f32x4 cs[2][2]; float rsv[2][4];
#pragma unroll
        for (int bj = 0; bj < 2; ++bj)
#pragma unroll
            for (int n = 0; n < 2; ++n) cs[bj][n] = *(const f32x4*)(CS + tc0 + bj * HALF + n * 16);
#pragma unroll
        for (int ai = 0; ai < 2; ++ai)
#pragma unroll
            for (int m = 0; m < 4; ++m) rsv[ai][m] = *(const float*)(U8 + ::u8_rs(rowb + ai * HALF + m * 16));
#pragma unroll
        for (int ai = 0; ai < 2; ++ai)
#pragma unroll
            for (int m = 0; m < 4; ++m)
#pragma unroll
                for (int bj = 0; bj < 2; ++bj)
#pragma unroll
                    for (int n = 0; n < 2; ++n) acc[ai][bj][m][n] = __builtin_convertvector(__builtin_bit_cast(i32x4, acc[ai][bj][m][n]), f32x4) * (cs[bj][n] * rsv[ai][m]);
        base(acc, u, wr, wc, fr, fq);
    }
};
#ifndef MK_STG_IN_MMA
#define MK_STG_IN_MMA 0
#endif
template <class Epi, class Sched, bool ALIGN_EPI = false, bool SP2 = false, int F8 = 0, int AUXA = 0, int AUXB = 0, int PFB = 0>
__device__ __forceinline__ void gemm_phase(PG8_LAS unsigned char* lds, const Gemm g, const Sched& S, const Epi& E, const int wave_sgpr) {
    int lane_ = ::mk_lane_id(); asm volatile("" : "+v"(lane_)); const int wid = wave_sgpr, tid = wid * 64 + lane_, lane = tid & 63, wr = wid >> 2, wc = wid & 3, fr = lane & 15, fq = lane >> 4;
    const int K = g.K, nt = K / BK, LDA = g.lda ? g.lda : K; const bool f8 = F8 == 2 ? g.f8 : (F8 == 1);
    unsigned voffA, voffB;
    { int R, C; stage_rc(tid * 16, R, C); const int Rb = Epi::PERM ? ((R & ~31) + perm32(R & 31)) : R;
        voffA = (unsigned)(R * LDA + C) * 2u; voffB = (unsigned)(Rb * K + C) * 2u; }
    const size_t qstep = (size_t)64 * K * 2, qstepA = (size_t)64 * LDA * 2;
    const size_t kstep = (size_t)(BK * 2);
    const size_t hstep = (size_t)HALF * K * 2, hstepA = (size_t)HALF * LDA * 2;
    const size_t tstep = 2 * hstep, tstepA = 2 * hstepA;
    const unsigned ldsw = (unsigned)wid * 1024u;
    const int aoff = lds_byte(wr * 64 + fr, fq * 8), boff = lds_byte(wc * 32 + fr, fq * 8);
#define PG8_SA(b, h) (((b) * 2 + (h)) * HTB)
#define PG8_SB(b, h) ((4 + (b) * 2 + (h)) * HTB)
#define PG8_STAGE_Q(bufoff, gbase, voff, qs, aux) do { const char* gb_ = (const char*)(gbase); asm volatile("" : "+s"(gb_)); const char* gb2_ = gb_ + (qs); asm volatile("" : "+s"(gb2_));        \
        unsigned vo_ = (voff); asm volatile("" : "+v"(vo_));        \
        __builtin_amdgcn_global_load_lds((const unsigned*)(gb_ + vo_), (PG8_LAS unsigned*)(lds + (bufoff) + ldsw), 16, 0, aux); \
        __builtin_amdgcn_global_load_lds((const unsigned*)(gb2_ + vo_), (PG8_LAS unsigned*)(lds + (bufoff) + ldsw + 8192), 16, 0, aux); } while (0)
#define PG8_STAGE(bufoff, gbase, voff) PG8_STAGE_Q(bufoff, gbase, voff, qstep, AUXB)
#define PG8_STAGEA(bufoff, gbase, voff) PG8_STAGE_Q(bufoff, gbase, voff, qstepA, AUXA)
#define PG8_LDA(dst, b, h) do { _Pragma("unroll") for (int m = 0; m < 4; ++m) _Pragma("unroll") for (int k = 0; k < 2; ++k) dst[m][k] = *(const PG8_LAS bf16x8*)(lds + PG8_SA(b, h) + aoff + m * 2048 + k * 1024); } while (0)
#define PG8_LDB(dst, b, h) do { _Pragma("unroll") for (int n = 0; n < 2; ++n) _Pragma("unroll") for (int k = 0; k < 2; ++k) dst[n][k] = *(const PG8_LAS bf16x8*)(lds + PG8_SB(b, h) + boff + n * 2048 + k * 1024); } while (0)
#define PG8_CAT(x) __builtin_bit_cast(i32x8, __builtin_shufflevector((x)[0], (x)[1], 0, 1, 2, 3, 4, 5, 6, 7, 8, 9, 10, 11, 12, 13, 14, 15))
#define PG8_MMA_R(ai, bj, At, Bt, m0, m1) do { __builtin_amdgcn_s_setprio(1); if constexpr (F8 == 3) { _Pragma("unroll") for (int m = (m0); m < (m1); ++m) _Pragma("unroll") for (int n = 0; n < 2; ++n) _Pragma("unroll") for (int k = 0; k < 2; ++k) \
        acc[ai][bj][m][n] = __builtin_bit_cast(f32x4, __builtin_amdgcn_mfma_i32_16x16x64_i8(__builtin_bit_cast(i32x4, Bt[n][k]), __builtin_bit_cast(i32x4, At[m][k]), __builtin_bit_cast(i32x4, acc[ai][bj][m][n]), 0, 0, 0)); } else if (f8) { _Pragma("unroll") for (int m = (m0); m < (m1); ++m) _Pragma("unroll") for (int n = 0; n < 2; ++n) \
        acc[ai][bj][m][n] = __builtin_amdgcn_mfma_scale_f32_16x16x128_f8f6f4(PG8_CAT(Bt[n]), PG8_CAT(At[m]), acc[ai][bj][m][n], 0, 0, 0, 0, 0, 0); } else { \
        _Pragma("unroll") for (int m = (m0); m < (m1); ++m) _Pragma("unroll") for (int n = 0; n < 2; ++n) _Pragma("unroll") for (int k = 0; k < 2; ++k) \
        acc[ai][bj][m][n] = __builtin_amdgcn_mfma_f32_16x16x32_bf16(Bt[n][k], At[m][k], acc[ai][bj][m][n], 0, 0, 0); } __builtin_amdgcn_s_setprio(0); } while (0)
#define PG8_MMA(ai, bj, At, Bt) PG8_MMA_R(ai, bj, At, Bt, 0, 4)
#define PG8_WAIT_V(n) asm volatile("s_waitcnt vmcnt(" #n ")" ::: "memory")
#define PG8_WAIT_L(n) asm volatile("s_waitcnt lgkmcnt(" #n ")" ::: "memory")
#define PG8_BAR __builtin_amdgcn_s_barrier()
#define PG8_SCHED __builtin_amdgcn_sched_barrier(0)
    Unit cur, nxt; int ui = 0;
    if (!S.next(0, cur)) return;
    f32x4 acc[2][2][4][2];
#pragma unroll
    for (int a = 0; a < 2; ++a)
#pragma unroll
        for (int b = 0; b < 2; ++b)
#pragma unroll
            for (int m = 0; m < 4; ++m)
#pragma unroll
                for (int n = 0; n < 2; ++n) acc[a][b][m][n] = (f32x4){0.f, 0.f, 0.f, 0.f};
    bf16x8 At[4][2], B0[2][2], B1[2][2];
    const char* cA = (const char*)g.A + (size_t)cur.pm * tstepA + (size_t)(cur.pm >> 4) * g.a_bgap; const char* cB = (const char*)g.Bt + (size_t)cur.pn * tstep;
    S.a_ready(cur);
    if constexpr (SP2) {
        PG8_STAGE(PG8_SB(0, 0), cB, voffB); PG8_STAGE(PG8_SB(0, 1), cB + hstep, voffB); PG8_STAGEA(PG8_SA(0, 0), cA, voffA); PG8_STAGEA(PG8_SA(0, 1), cA + hstepA, voffA);
        if (wr == 1) PG8_BAR;
        PG8_WAIT_V(2); PG8_BAR;
        PG8_STAGE(PG8_SB(1, 0), cB + kstep, voffB); PG8_STAGEA(PG8_SA(1, 0), cA + kstep, voffA); PG8_STAGE(PG8_SB(1, 1), cB + hstep + kstep, voffB);
        PG8_WAIT_V(6); PG8_BAR;
    } else {
        PG8_STAGE(PG8_SB(0, 0), cB, voffB); PG8_STAGEA(PG8_SA(0, 0), cA, voffA); PG8_STAGE(PG8_SB(0, 1), cB + hstep, voffB); PG8_STAGEA(PG8_SA(0, 1), cA + hstepA, voffA);
        if (wr == 1) PG8_BAR;
        PG8_WAIT_V(4); PG8_BAR;
        PG8_STAGE(PG8_SB(1, 0), cB + kstep, voffB); PG8_STAGEA(PG8_SA(1, 0), cA + kstep, voffA); PG8_STAGE(PG8_SB(1, 1), cB + hstep + kstep, voffB);
        PG8_WAIT_V(6); PG8_BAR;
    }
    for (;;) {
        const bool has_next = S.next(ui + 1, nxt);
        const char* nA = has_next ? (const char*)g.A + (size_t)nxt.pm * tstepA + (size_t)(nxt.pm >> 4) * g.a_bgap : cA; const char* nB = has_next ? (const char*)g.Bt + (size_t)nxt.pn * tstep : cB;
        for (int t = 0; t < nt; t += 2) {
            const bool last = (t == nt - 2);
            const char* a1 = cA + (size_t)(t + 1) * kstep;
            const char* a2 = last ? nA : cA + (size_t)(t + 2) * kstep; const char* b2 = last ? nB : cB + (size_t)(t + 2) * kstep;
            const char* a3 = a2 + kstep; const char* b3 = b2 + kstep;
            if (last && has_next) S.a_ready(nxt);
            if constexpr (SP2) {
#if MK_STG_IN_MMA
            PG8_LDB(B0, 0, 0); PG8_LDB(B1, 0, 1); PG8_SCHED; PG8_LDA(At, 0, 0);
            PG8_WAIT_V(6); PG8_WAIT_L(0); PG8_BAR; PG8_MMA_R(0, 0, At, B0, 0, 1); PG8_STAGEA(PG8_SA(1, 1), a1 + hstepA, voffA); PG8_MMA_R(0, 0, At, B0, 1, 4); PG8_MMA(0, 1, At, B1); PG8_BAR; PG8_SCHED;
            PG8_LDA(At, 0, 1);
            PG8_WAIT_V(2); PG8_WAIT_L(0); PG8_BAR; PG8_MMA_R(1, 0, At, B0, 0, 1); PG8_STAGE(PG8_SB(0, 0), b2, voffB); PG8_MMA_R(1, 0, At, B0, 1, 2); PG8_STAGE(PG8_SB(0, 1), b2 + hstep, voffB); PG8_MMA_R(1, 0, At, B0, 2, 3); PG8_STAGEA(PG8_SA(0, 0), a2, voffA); PG8_MMA_R(1, 0, At, B0, 3, 4); PG8_MMA(1, 1, At, B1); PG8_BAR; PG8_SCHED;
            PG8_LDB(B0, 1, 0); PG8_LDB(B1, 1, 1); PG8_SCHED; PG8_LDA(At, 1, 0);
            PG8_WAIT_V(6); PG8_WAIT_L(0); PG8_BAR; PG8_MMA_R(0, 0, At, B0, 0, 1); PG8_STAGEA(PG8_SA(0, 1), a2 + hstepA, voffA); PG8_MMA_R(0, 0, At, B0, 1, 4); PG8_MMA(0, 1, At, B1); PG8_BAR; PG8_SCHED;
            PG8_LDA(At, 1, 1);
            PG8_WAIT_V(2); PG8_WAIT_L(0); PG8_BAR; PG8_MMA_R(1, 0, At, B0, 0, 1); PG8_STAGE(PG8_SB(1, 0), b3, voffB); PG8_MMA_R(1, 0, At, B0, 1, 2); PG8_STAGE(PG8_SB(1, 1), b3 + hstep, voffB); PG8_MMA_R(1, 0, At, B0, 2, 3); PG8_STAGEA(PG8_SA(1, 0), a3, voffA); PG8_MMA_R(1, 0, At, B0, 3, 4); PG8_MMA(1, 1, At, B1); PG8_BAR; PG8_SCHED;
#else
            PG8_LDB(B0, 0, 0); PG8_LDB(B1, 0, 1); PG8_SCHED; PG8_LDA(At, 0, 0); PG8_STAGEA(PG8_SA(1, 1), a1 + hstepA, voffA);
            PG8_WAIT_V(8); PG8_WAIT_L(0); PG8_BAR; PG8_MMA(0, 0, At, B0); PG8_MMA(0, 1, At, B1); PG8_BAR; PG8_SCHED;
            PG8_LDA(At, 0, 1); PG8_STAGE(PG8_SB(0, 0), b2, voffB); PG8_STAGE(PG8_SB(0, 1), b2 + hstep, voffB); PG8_STAGEA(PG8_SA(0, 0), a2, voffA);
            PG8_WAIT_V(8); PG8_WAIT_L(0); PG8_BAR; PG8_MMA(1, 0, At, B0); PG8_MMA(1, 1, At, B1); PG8_BAR; PG8_SCHED;
            PG8_LDB(B0, 1, 0); PG8_LDB(B1, 1, 1); PG8_SCHED; PG8_LDA(At, 1, 0); PG8_STAGEA(PG8_SA(0, 1), a2 + hstepA, voffA);
            PG8_WAIT_V(8); PG8_WAIT_L(0); PG8_BAR; PG8_MMA(0, 0, At, B0); PG8_MMA(0, 1, At, B1); PG8_BAR; PG8_SCHED;
            PG8_LDA(At, 1, 1); PG8_STAGE(PG8_SB(1, 0), b3, voffB); PG8_STAGE(PG8_SB(1, 1), b3 + hstep, voffB); PG8_STAGEA(PG8_SA(1, 0), a3, voffA);
            PG8_WAIT_V(8); PG8_WAIT_L(0); PG8_BAR; PG8_MMA(1, 0, At, B0); PG8_MMA(1, 1, At, B1); PG8_BAR; PG8_SCHED;
#endif
            } else {
            PG8_LDB(B0, 0, 0); PG8_SCHED; PG8_LDA(At, 0, 0); PG8_STAGEA(PG8_SA(1, 1), a1 + hstepA, voffA);
            PG8_WAIT_L(8); PG8_BAR; PG8_WAIT_L(0); PG8_MMA(0, 0, At, B0); PG8_BAR; PG8_SCHED;
            PG8_LDB(B1, 0, 1); PG8_STAGE(PG8_SB(0, 0), b2, voffB);
            PG8_BAR; PG8_WAIT_L(0); PG8_MMA(0, 1, At, B1); PG8_BAR;
            PG8_LDA(At, 0, 1); PG8_STAGEA(PG8_SA(0, 0), a2, voffA);
            PG8_BAR; PG8_WAIT_L(0); PG8_MMA(1, 0, At, B0); PG8_BAR; PG8_SCHED;
            PG8_STAGE(PG8_SB(0, 1), b2 + hstep, voffB);
            PG8_WAIT_V(6); PG8_BAR; PG8_MMA(1, 1, At, B1); PG8_BAR;
            PG8_LDB(B0, 1, 0); PG8_SCHED; PG8_LDA(At, 1, 0); PG8_STAGEA(PG8_SA(0, 1), a2 + hstepA, voffA);
            PG8_WAIT_L(8); PG8_BAR; PG8_WAIT_L(0); PG8_MMA(0, 0, At, B0); PG8_BAR; PG8_SCHED;
            PG8_LDB(B1, 1, 1); PG8_STAGE(PG8_SB(1, 0), b3, voffB);
            PG8_BAR; PG8_WAIT_L(0); PG8_MMA(0, 1, At, B1); PG8_BAR;
            PG8_LDA(At, 1, 1); PG8_STAGEA(PG8_SA(1, 0), a3, voffA);
            PG8_BAR; PG8_WAIT_L(0); PG8_MMA(1, 0, At, B0); PG8_BAR; PG8_SCHED;
            PG8_STAGE(PG8_SB(1, 1), b3 + hstep, voffB);
            PG8_WAIT_V(6); PG8_BAR; PG8_MMA(1, 1, At, B1); PG8_BAR;
            }
        }
        if constexpr (ALIGN_EPI) { if (wr == 0) PG8_BAR; }
        if constexpr (!Epi::AFTER_DRAIN) { E(acc, cur, wr, wc, fr, fq); S.done(cur); }
        if (!has_next) break;
#pragma unroll
        for (int a = 0; a < 2; ++a)
#pragma unroll
            for (int b = 0; b < 2; ++b)
#pragma unroll
                for (int m = 0; m < 4; ++m)
#pragma unroll
                    for (int n = 0; n < 2; ++n) acc[a][b][m][n] = (f32x4){0.f, 0.f, 0.f, 0.f};
        cur = nxt; cA = nA; cB = nB; ++ui;
        if constexpr (ALIGN_EPI) { if (wr == 1) PG8_BAR; }
    }
    PG8_WAIT_V(0);
    if constexpr (!ALIGN_EPI) { if (wr == 0) PG8_BAR; }
    PG8_BAR;
    if constexpr (Epi::AFTER_DRAIN) { E.fused(acc, cur, wr, wc, fr, fq, lds, wid, lane); S.done(cur); }
#undef PG8_SA
#undef PG8_SB
#undef PG8_STAGE
#undef PG8_STAGEA
#undef PG8_STAGE_Q
#undef PG8_LDA
#undef PG8_LDB
#undef PG8_MMA
#undef PG8_MMA_R
#undef PG8_CAT
#undef PG8_WAIT_V
#undef PG8_WAIT_L
#undef PG8_BAR
#undef PG8_SCHED
}
}
#ifndef PG8_DUMMY_END
#endif
#define XB_TMO      128
#define XB_XCNT(j)  (256  + 64 * (j))
#define XB_XSUB(j)  (1280 + 64 * (j))
#define XB_XGEN(j)  (2304 + 64 * (j))
#define XB_TOP      3328
#define XB_TOPGEN   3392
#define XCD_BAR_WORDS 3456
#define XB_SPIN_CAP (1u << 18)

__device__ __forceinline__ unsigned xb_ld(unsigned* p)              { return __hip_atomic_load(p, __ATOMIC_RELAXED, __HIP_MEMORY_SCOPE_AGENT); }
__device__ __forceinline__ unsigned xb_add(unsigned* p, unsigned v) { return __hip_atomic_fetch_add(p, v, __ATOMIC_RELAXED, __HIP_MEMORY_SCOPE_AGENT); }
__device__ __forceinline__ unsigned xb_xcc_id() { return (unsigned)__builtin_amdgcn_s_getreg((3 << 11) | 20) & 0xFu; }
#define XB_SPIN(cond, bar) do { unsigned _sp = 0; while (cond) { __builtin_amdgcn_s_sleep(1); \
    if ((++_sp & 255u) == 0u) { if (xb_ld(&(bar)[XB_TMO])) break; if (_sp > XB_SPIN_CAP) { atomicAdd(&(bar)[XB_TMO], 1u); break; } } } } while (0)

struct XcdBarrier {
    int wv;
    unsigned* bar; unsigned x;
    volatile LAS unsigned* st;
};

__device__ __forceinline__ XcdBarrier xcd_barrier_post(unsigned* bar, volatile LAS unsigned* st, int wv) {
    XcdBarrier b; b.wv = wv; b.bar = bar; b.x = xb_xcc_id(); b.st = st;
    if (wv == 0 && mk_lane_id() == 0) (void)xb_add(&bar[XB_XCNT(b.x)], 1u);
    return b;
}
__device__ __forceinline__ void xcd_barrier_complete(unsigned* bar, unsigned x, unsigned& nloc, unsigned& nx) {
    const unsigned G = gridDim.x * gridDim.y * gridDim.z;
    unsigned sum, cnt, mine, sp = 0u;
    for (;;) {
        sum = 0u; cnt = 0u; mine = 0u;
#pragma unroll
        for (unsigned j = 0; j < 16; ++j) { const unsigned c = xb_ld(&bar[XB_XCNT(j)]); sum += c; cnt += (c > 0u) ? 1u : 0u; mine = (j == x) ? c : mine; }
        if (sum == G) break;
        __builtin_amdgcn_s_sleep(1);
        if ((++sp & 255u) == 0u) { if (xb_ld(&bar[XB_TMO])) break; if (sp > XB_SPIN_CAP) { atomicAdd(&bar[XB_TMO], 1u); break; } }
    }
    nloc = mine > 0u ? mine : 1u; nx = cnt > 0u ? cnt : 1u;
}

__device__ __forceinline__ void xcd_barrier(const XcdBarrier& b) {
    asm volatile("s_waitcnt vmcnt(0)" ::: "memory");
    __syncthreads();
    if (b.wv == 0 && mk_lane_id() == 0) {
        unsigned* bar = b.bar;
        __builtin_amdgcn_s_waitcnt(0);
        unsigned nloc = b.st[0], nx = b.st[1];
        if (nloc == 0u) { xcd_barrier_complete(bar, b.x, nloc, nx); b.st[0] = nloc; b.st[1] = nx; }
        const unsigned old = xb_add(&bar[XB_XSUB(b.x)], 1u);
        const unsigned gen = old / nloc;
        if (old + 1u == (gen + 1u) * nloc) {
            __builtin_amdgcn_fence(__ATOMIC_RELEASE, "agent");
            asm volatile("s_waitcnt vmcnt(0)" ::: "memory");
            const unsigned og = xb_add(&bar[XB_TOP], 1u);
            const unsigned tg = og / nx;
            if (og + 1u == (tg + 1u) * nx) xb_add(&bar[XB_TOPGEN], 1u);
            else XB_SPIN(xb_ld(&bar[XB_TOPGEN]) == tg, bar);
            __builtin_amdgcn_fence(__ATOMIC_ACQUIRE, "agent");
            xb_add(&bar[XB_XGEN(b.x)], 1u);
            asm volatile("s_waitcnt vmcnt(0)" ::: "memory");
        } else {
            XB_SPIN(xb_ld(&bar[XB_XGEN(b.x)]) == gen, bar);
            __builtin_amdgcn_fence(__ATOMIC_ACQUIRE, "agent");
            asm volatile("s_waitcnt vmcnt(0)" ::: "memory");
        }
    }
    __syncthreads();
}

#ifndef MK_LOCAL_NOWB
#define MK_LOCAL_NOWB 1
#endif
__device__ __forceinline__ void xcd_barrier_local(const XcdBarrier& b) {
    asm volatile("s_waitcnt vmcnt(0)" ::: "memory");
    __syncthreads();
    if (b.wv == 0 && mk_lane_id() == 0) {
        unsigned* bar = b.bar;
        __builtin_amdgcn_s_waitcnt(0);
        unsigned nloc = b.st[0], nx = b.st[1];
        if (nloc == 0u) { xcd_barrier_complete(bar, b.x, nloc, nx); b.st[0] = nloc; b.st[1] = nx; }
        const unsigned old = xb_add(&bar[XB_XSUB(b.x)], 1u);
        const unsigned gen = old / nloc;
        if (old + 1u == (gen + 1u) * nloc) {
#if !MK_LOCAL_NOWB
            __builtin_amdgcn_fence(__ATOMIC_RELEASE, "agent");
            asm volatile("s_waitcnt vmcnt(0)" ::: "memory");
#endif
            __builtin_amdgcn_fence(__ATOMIC_ACQUIRE, "agent");
            xb_add(&bar[XB_XGEN(b.x)], 1u);
            asm volatile("s_waitcnt vmcnt(0)" ::: "memory");
        } else {
            XB_SPIN(xb_ld(&bar[XB_XGEN(b.x)]) == gen, bar);
            __builtin_amdgcn_fence(__ATOMIC_ACQUIRE, "agent");
            asm volatile("s_waitcnt vmcnt(0)" ::: "memory");
        }
    }
    __syncthreads();
}

#endif
#ifndef MK_BATCH
#define MK_BATCH 8
#endif
constexpr int BATCH = MK_BATCH, SEQ = 4096, DM = 1024, DEPTH = 4, DFF = 2816, NUP = 5632, NIN = 2048, NINF = 2056;
constexpr int M = BATCH * SEQ, NBH = BATCH * 4, NCH = SEQ / 64;
constexpr float EPS = 1e-6f, NEGF = -1e30f, LOG2E = 1.4426950408889634f;
constexpr size_t MiB = 1u << 20;
constexpr size_t WS_CTL = 0, CTL_ZERO_BYTES = 1 * MiB;
constexpr size_t WS_MOD = 1 * MiB;
constexpr size_t WS_GWT = 3 * MiB;
constexpr size_t WS_PWT = 3 * MiB + 256 * 1024;
constexpr size_t WS_WQT = 4 * MiB;
constexpr size_t WS_SM = 6 * MiB;
constexpr size_t SM_PRE = WS_SM, SM_POST = SM_PRE + 49152, SM_GATEB = SM_POST + 49152, SM_POOLS = SM_GATEB + 256, SM_CONVW = SM_POOLS + 4096, SM_CONVB = SM_CONVW + 32768, SM_NORMW = SM_CONVB + 8192, SM_SKIP = SM_NORMW + 8192;
constexpr size_t WS_WUP = 8 * MiB;
constexpr size_t WS_WDN = 96 * MiB;
constexpr size_t WS_WIN = 140 * MiB;
constexpr size_t WS_WOUT = 156 * MiB;
constexpr size_t WS_U = 164 * MiB;
constexpr size_t WS_Y = 228 * MiB;
constexpr size_t WS_BIG = 292 * MiB;
constexpr size_t WS_HID = WS_BIG;
constexpr size_t WS_Q16 = WS_BIG, WS_K16 = WS_BIG + 16 * MiB, WS_VT16 = WS_BIG + 32 * MiB, WS_PIN = WS_BIG + 48 * MiB;
constexpr size_t WS_XM = WS_BIG + 64 * MiB, WS_OG = WS_BIG + 96 * MiB, WS_XC = WS_BIG + 128 * MiB;
constexpr size_t WS_MQ = WS_BIG + 160 * MiB, WS_MK = WS_BIG + 192 * MiB, WS_MVT = WS_BIG + 224 * MiB;
constexpr size_t WS_DCT = WS_BIG + 256 * MiB;
constexpr size_t WS_HB = WS_BIG + 320 * MiB;
constexpr size_t WS_DN = WS_BIG + 384 * MiB;
constexpr size_t WS_GI = WS_BIG + 385 * MiB, WS_GF = WS_GI + 512 * 1024;
constexpr size_t WS_BCUM = WS_BIG + 386 * MiB;
constexpr size_t WS_BL = WS_BCUM + 512 * 1024, WS_AM = WS_BL + 8192, WS_MP = WS_AM + 8192;
constexpr size_t WIN_CS = 3 * MiB;
constexpr size_t WUP_SLOT = (size_t)NUP * 1024 * 2, WUP_CS = 8 * MiB;
constexpr size_t WS_END = WS_BIG + 388 * MiB;

typedef unsigned short bf16_t;
typedef short bf16x8 __attribute__((ext_vector_type(8)));
typedef float f32x4 __attribute__((ext_vector_type(4)));
typedef unsigned u32x4 __attribute__((ext_vector_type(4)));
typedef unsigned u32x2 __attribute__((ext_vector_type(2)));

struct Ctx { int wv, blk, nblk, vb; LAS unsigned char* lds; float* out; unsigned char* ws; };
#define PHASE_LOCALS const int lane = lnd(mk_lane_id()), wave = C.wv, tid = wave * 64 + lane, vblk = C.vb, gw = vblk * 8 + wave, ngw = C.nblk * 8; unsigned char* const ws = lndp(C.ws); (void)lane; (void)wave; (void)gw; (void)ngw; (void)ws;
enum { I_X = 0, I_C, I_ADAW, I_ADAB, I_PRE, I_POST, I_UP, I_DOWN, I_MIXIN, I_MIXOUT, I_POOLW, I_POOLS, I_CONVW, I_CONVB, I_QKVW, I_GATEB, I_NORMW, I_SKIP };

DEV float bf2f(unsigned b) { return __builtin_bit_cast(float, b << 16); }
DEV float bflo(unsigned w) { return __builtin_bit_cast(float, w << 16); }
DEV float bfhi(unsigned w) { return __builtin_bit_cast(float, w & 0xffff0000u); }
DEV bf16x8 mk8(unsigned a, unsigned b, unsigned c, unsigned d) { u32x4 w; w.x = a; w.y = b; w.z = c; w.w = d; return __builtin_bit_cast(bf16x8, w); }
DEV bf16x8 pack8(f32x4 a, f32x4 b) { return mk8(pk2(a[0], a[1]), pk2(a[2], a[3]), pk2(b[0], b[1]), pk2(b[2], b[3])); }
#ifdef EMU
DEV float wave_sum(float v) {
#pragma unroll
    for (int o = 1; o < 64; o <<= 1) v += __shfl_xor(v, o);
    return v; }
DEV float wave_max(float v) {
#pragma unroll
    for (int o = 1; o < 64; o <<= 1) v = fmaxf(v, __shfl_xor(v, o));
    return v; }
DEV float wave_prefix_sum(float v) { const int ln = mk_lane_id();
#pragma unroll
    for (int o = 1; o < 64; o <<= 1) { const float t = __shfl_up(v, o); if (ln >= o) v += t; }
    return v; }
DEV float lane63(float v) { return __shfl(v, 63); }
#else
template <int CTRL, int RM> DEV float dpp_add(float v) { return v + __builtin_bit_cast(float, __builtin_amdgcn_update_dpp(0, __builtin_bit_cast(int, v), CTRL, RM, 0xf, true)); }
DEV float wave_sum(float v) {
    v = dpp_add<0xB1, 0xf>(v); v = dpp_add<0x4E, 0xf>(v); v = dpp_add<0x141, 0xf>(v); v = dpp_add<0x140, 0xf>(v);
    v = dpp_add<0x142, 0xa>(v); v = dpp_add<0x143, 0xc>(v);
    return __builtin_bit_cast(float, __builtin_amdgcn_readlane(__builtin_bit_cast(int, v), 63)); }
template <int CTRL, int RM> DEV float dpp_max(float v) { return fmaxf(v, __builtin_bit_cast(float, __builtin_amdgcn_update_dpp(__builtin_bit_cast(int, v), __builtin_bit_cast(int, v), CTRL, RM, 0xf, false))); }
DEV float wave_max(float v) {
    v = dpp_max<0xB1, 0xf>(v); v = dpp_max<0x4E, 0xf>(v); v = dpp_max<0x141, 0xf>(v); v = dpp_max<0x140, 0xf>(v);
    v = dpp_max<0x142, 0xa>(v); v = dpp_max<0x143, 0xc>(v);
    return __builtin_bit_cast(float, __builtin_amdgcn_readlane(__builtin_bit_cast(int, v), 63)); }
template <int CTRL, int RM> DEV float dpp_add0(float v) { return v + __builtin_bit_cast(float, __builtin_amdgcn_update_dpp(0, __builtin_bit_cast(int, v), CTRL, RM, 0xf, false)); }
DEV float wave_prefix_sum(float v) {
    v = dpp_add0<0x111, 0xf>(v); v = dpp_add0<0x112, 0xf>(v); v = dpp_add0<0x114, 0xf>(v); v = dpp_add0<0x118, 0xf>(v);
    v = dpp_add0<0x142, 0xa>(v); v = dpp_add0<0x143, 0xc>(v); return v; }
DEV float lane63(float v) { return __builtin_bit_cast(float, __builtin_amdgcn_readlane(__builtin_bit_cast(int, v), 63)); }
#endif
DEV float quad_sum(float v) { v += __shfl_xor(v, 16); v += __shfl_xor(v, 32); return v; }
DEV float quad_max(float v) { v = fmaxf(v, __shfl_xor(v, 16)); v = fmaxf(v, __shfl_xor(v, 32)); return v; }
DEV float sigmoid_f(float x) { return fast_rcp(1.0f + __expf(-x)); }

DEV void phase_mod(Ctx& C, const float* c, const float* adaw, const float* adab) {
    PHASE_LOCALS
    float* mod = (float*)(ws + WS_MOD);
    LAS float* cact = (LAS float*)C.lds; LAS float* part = cact + BATCH * 1024;
    for (int i = tid; i < BATCH * 1024; i += 512) { const float v = c[i]; cact[i] = v * sigmoid_f(v); }
    __syncthreads();
    const int ks = tid >> 6, col = tid & 63;
    for (int u = C.blk; u < DEPTH * 9216 / 64; u += C.nblk) {
        const int n = u * 64 + col, l = n / 9216, nn = n % 9216;
        const float* w = adaw + ((size_t)l * 1024 + ks * 128) * 9216 + nn;
        float acc[BATCH];
#pragma unroll
        for (int b = 0; b < BATCH; ++b) acc[b] = 0.f;
#pragma unroll 4
        for (int k = 0; k < 128; ++k) { const float wv = w[(size_t)k * 9216];
#pragma unroll
            for (int b = 0; b < BATCH; ++b) acc[b] += cact[b * 1024 + ks * 128 + k] * wv; }
#pragma unroll
        for (int b = 0; b < BATCH; ++b) part[(ks * 64 + col) * BATCH + b] = acc[b];
        __syncthreads();
        for (int idx = tid; idx < BATCH * 64; idx += 512) { const int b = idx >> 6, cc = idx & 63; float s = 0.f;
#pragma unroll
            for (int k2 = 0; k2 < 8; ++k2) s += part[(k2 * 64 + cc) * BATCH + b];
            const int n2 = u * 64 + cc, l2 = n2 / 9216, nn2 = n2 % 9216;
            mod[((size_t)l2 * BATCH + b) * 9216 + nn2] = s + adab[l2 * 9216 + nn2]; }
        __syncthreads();
    }
}

DEV void transpose_item(const float* W, int pitch, int K, bf16_t* WT, int nblk, int item, int kind, LAS float* scr, int lane, float sc_gate = 1.0f, float sc_val = 1.0f) {
    const int kb = item / nblk, nb = item % nblk, k0 = 64 * kb, n0 = 32 * nb;
    int drow0 = n0;
    if (kind == 1) { const int t = n0 >= DFF ? 1 : 0, j = n0 - t * DFF; drow0 = 256 * (j >> 7) + 128 * t + (j & 127); }
    f32x4 wv4[8];
#pragma unroll
    for (int i = 0; i < 8; ++i) wv4[i] = *(const f32x4*)(W + (size_t)(k0 + 8 * i + (lane >> 3)) * pitch + n0 + 4 * (lane & 7));
#pragma unroll
    for (int i = 0; i < 8; ++i) { LAS float* d = scr + (8 * i + (lane >> 3)) * 33 + 4 * (lane & 7); d[0] = wv4[i][0]; d[1] = wv4[i][1]; d[2] = wv4[i][2]; d[3] = wv4[i][3]; }
    WAVE_LDS_SYNC();
    const int c = lane & 7;
#pragma unroll
    for (int j = 0; j < 4; ++j) { const int n = (lane >> 3) + 8 * j; const LAS float* s = scr + (8 * c) * 33 + n;
        if (kind == 2) {
            mk_u32x2 o8; o8.x = pk_fp8x4(s[0 * 33] * F8_SW, s[1 * 33] * F8_SW, s[2 * 33] * F8_SW, s[3 * 33] * F8_SW); o8.y = pk_fp8x4(s[4 * 33] * F8_SW, s[5 * 33] * F8_SW, s[6 * 33] * F8_SW, s[7 * 33] * F8_SW);
            *(mk_u32x2*)((unsigned char*)WT + (size_t)(drow0 + n) * K + k0 + 8 * c) = o8; continue; }
        if (kind == 1) { const float sc = n0 >= DFF ? sc_val : sc_gate;
            u32x4 o1; o1.x = pk2(s[0 * 33] * sc, s[1 * 33] * sc); o1.y = pk2(s[2 * 33] * sc, s[3 * 33] * sc); o1.z = pk2(s[4 * 33] * sc, s[5 * 33] * sc); o1.w = pk2(s[6 * 33] * sc, s[7 * 33] * sc);
            *(u32x4*)(WT + (size_t)(drow0 + n) * K + k0 + 8 * c) = o1; continue; }
        u32x4 o; o.x = pk2(s[0 * 33], s[1 * 33]); o.y = pk2(s[2 * 33], s[3 * 33]); o.z = pk2(s[4 * 33], s[5 * 33]); o.w = pk2(s[6 * 33], s[7 * 33]);
        *(u32x4*)(WT + (size_t)(drow0 + n) * K + k0 + 8 * c) = o; }
    WAVE_LDS_SYNC();
}
DEV void convert_up_i8(const float* W, unsigned char* W8, float* CS, int nb, float sc_gate, float sc_val, LAS float* scr, LAS float* smax, int wave, int lane, int pitch = NUP, bool plain = false) {
    const int n0 = 32 * nb, t = (!plain && n0 >= DFF) ? 1 : 0, j0 = n0 - t * DFF, drow0 = plain ? n0 : 256 * (j0 >> 7) + 128 * t + (j0 & 127);
    f32x4 wv[16];
#pragma unroll
    for (int i = 0; i < 16; ++i) wv[i] = *(const f32x4*)(W + (size_t)(128 * wave + 8 * i + (lane >> 3)) * pitch + n0 + 4 * (lane & 7));
    f32x4 cm = {0.f, 0.f, 0.f, 0.f};
#pragma unroll
    for (int i = 0; i < 16; ++i)
#pragma unroll
        for (int e = 0; e < 4; ++e) cm[e] = fmaxf(cm[e], fabsf(wv[i][e]));
#pragma unroll
    for (int e = 0; e < 4; ++e) { cm[e] = fmaxf(cm[e], __shfl_xor(cm[e], 8)); cm[e] = fmaxf(cm[e], __shfl_xor(cm[e], 16)); cm[e] = fmaxf(cm[e], __shfl_xor(cm[e], 32)); }
    if (lane < 8) { LAS float* d = smax + wave * 32 + 4 * lane; d[0] = cm[0]; d[1] = cm[1]; d[2] = cm[2]; d[3] = cm[3]; }
    __syncthreads();
    f32x4 am = {0.f, 0.f, 0.f, 0.f};
#pragma unroll
    for (int w2 = 0; w2 < 8; ++w2) { const LAS float* s = smax + w2 * 32 + 4 * (lane & 7);
#pragma unroll
        for (int e = 0; e < 4; ++e) am[e] = fmaxf(am[e], s[e]); }
    f32x4 inv;
#pragma unroll
    for (int e = 0; e < 4; ++e) inv[e] = am[e] > 0.f ? 127.0f / am[e] : 0.f;
    if (wave == 0 && lane < 8) { const float sc = (plain ? 1.0f : (t ? sc_val : sc_gate)) * (1.0f / 127.0f); *(f32x4*)(CS + t * DFF + j0 + 4 * lane) = am * sc; }
#pragma unroll
    for (int kb2 = 0; kb2 < 2; ++kb2) {
#pragma unroll
        for (int i = 0; i < 8; ++i) { LAS float* d = scr + (8 * i + (lane >> 3)) * 33 + 4 * (lane & 7); const f32x4 v = wv[8 * kb2 + i] * inv; d[0] = v[0]; d[1] = v[1]; d[2] = v[2]; d[3] = v[3]; }
        WAVE_LDS_SYNC();
        const int c = lane & 7;
#pragma unroll
        for (int j = 0; j < 4; ++j) { const int n = (lane >> 3) + 8 * j; const LAS float* s = scr + (8 * c) * 33 + n;
            mk_u32x2 o; o.x = pk_i8x4(s[0 * 33], s[1 * 33], s[2 * 33], s[3 * 33]); o.y = pk_i8x4(s[4 * 33], s[5 * 33], s[6 * 33], s[7 * 33]);
            *(mk_u32x2*)(W8 + (size_t)(drow0 + n) * 1024 + 128 * wave + 64 * kb2 + 8 * c) = o; }
        WAVE_LDS_SYNC();
    }
    __syncthreads();
}
constexpr int IT_UP = 16 * 176, IT_DN = 44 * 32, IT_IN = 16 * 64, IT_OUT = 16 * 32, IT_LAYER = 2 * IT_UP + 2 * IT_DN + IT_IN + IT_OUT;
struct CvtIn { const float *up, *down, *mixin, *mixout, *poolw, *qkvw, *pre, *post, *gateb, *pools, *convw, *convb, *normw, *skip; };
DEV void copy_f32(const float* src, float* dst, int n, int gt, int ngt) { for (int i = gt; i < n; i += ngt) dst[i] = src[i]; }
DEV void phase_convert(Ctx& C, const CvtIn& I) {
    PHASE_LOCALS
    LAS float* scr = (LAS float*)(C.lds + wave * 8704);
    if (MK_I8MASK) { LAS float* smax = (LAS float*)(C.lds + 8 * 8704);
        for (int hh = vblk; hh < DEPTH * 2 * 176; hh += C.nblk) { const int s = hh / 176, nb = hh % 176;
            if (!((MK_I8MASK >> s) & 1)) continue;
            convert_up_i8(I.up + (size_t)s * 1024 * NUP, ws + WS_WUP + (size_t)s * WUP_SLOT, (float*)(ws + WS_WUP + (size_t)s * WUP_SLOT + WUP_CS), nb, UPW_GATE, ((MK_F8MASK >> s) & 1) ? UPW_VAL * F8_SH : UPW_VAL, scr, smax, wave, lane); } }
    if (MK_I8IN) { LAS float* smax = (LAS float*)(C.lds + 8 * 8704);
        for (int hh = vblk; hh < DEPTH * 64; hh += C.nblk) { const int l = hh / 64, nb = hh % 64;
            convert_up_i8(I.mixin + (size_t)l * 1024 * NINF, ws + WS_WIN + (size_t)l * NIN * 1024 * 2, (float*)(ws + WS_WIN + (size_t)l * NIN * 1024 * 2 + WIN_CS), nb, 1.0f, 1.0f, scr, smax, wave, lane, NINF, true); } }
    for (int it = gw; it < DEPTH * IT_LAYER; it += ngw) {
        const int l = it / IT_LAYER; int r = it % IT_LAYER;
        if (r < 2 * IT_UP) { const int f = r / IT_UP; r -= f * IT_UP;
            if ((MK_I8MASK >> (l * 2 + f)) & 1) continue;
            transpose_item(I.up + (size_t)(l * 2 + f) * 1024 * NUP, NUP, 1024, (bf16_t*)(ws + WS_WUP) + (size_t)(l * 2 + f) * NUP * 1024, 176, r, 1, scr, lane, UPW_GATE, ((MK_F8MASK >> (l * 2 + f)) & 1) ? UPW_VAL * F8_SH : UPW_VAL); continue; }
        r -= 2 * IT_UP;
        if (r < 2 * IT_DN) { const int f = r / IT_DN; r -= f * IT_DN;
            transpose_item(I.down + (size_t)(l * 2 + f) * DFF * 1024, 1024, DFF, (bf16_t*)(ws + WS_WDN) + (size_t)(l * 2 + f) * 1024 * DFF, 32, r, ((MK_F8MASK >> (l * 2 + f)) & 1) ? 2 : 0, scr, lane); continue; }
        r -= 2 * IT_DN;
        if (r < IT_IN) { if (MK_I8IN) continue; transpose_item(I.mixin + (size_t)l * 1024 * NINF, NINF, 1024, (bf16_t*)(ws + WS_WIN) + (size_t)l * NIN * 1024, 64, r, 0, scr, lane); continue; }
        r -= IT_IN;
        transpose_item(I.mixout + (size_t)l * 1024 * 1024, 1024, 1024, (bf16_t*)(ws + WS_WOUT) + (size_t)l * 1024 * 1024, 32, r, 0, scr, lane);
    }
    const int gt = C.blk * 512 + tid, ngt = C.nblk * 512;
    bf16_t* pwt = (bf16_t*)(ws + WS_PWT); const float* pw = I.poolw;
    for (int i = gt; i < DEPTH * 4 * 64 * 64; i += ngt) { const int c = i & 63, e = (i >> 6) & 63, lg = i >> 12; pwt[i] = (bf16_t)f2bf(pw[((size_t)lg * 64 + c) * 64 + e]); }
    bf16_t* wqt = (bf16_t*)(ws + WS_WQT); const float* qw = I.qkvw;
    for (int i = gt; i < DEPTH * 3 * 4 * 128 * 128; i += ngt) { const int d = i & 127, e = (i >> 7) & 127, lwh = i >> 14; wqt[i] = (bf16_t)f2bf(qw[((size_t)lwh * 128 + d) * 128 + e]); }
    float* gwt = (float*)(ws + WS_GWT); const float* mi = I.mixin;
    for (int i = gt; i < DEPTH * 8 * 1024; i += ngt) { const int c = i & 1023, j = (i >> 10) & 7, l = i >> 13; gwt[i] = mi[((size_t)l * 1024 + c) * NINF + NIN + j]; }
    copy_f32(I.pre, (float*)(ws + SM_PRE), DEPTH * 3 * 1024, gt, ngt); copy_f32(I.post, (float*)(ws + SM_POST), DEPTH * 3 * 1024, gt, ngt); copy_f32(I.gateb, (float*)(ws + SM_GATEB), DEPTH * 8, gt, ngt);
    copy_f32(I.pools, (float*)(ws + SM_POOLS), DEPTH * 256, gt, ngt); copy_f32(I.convw, (float*)(ws + SM_CONVW), DEPTH * 4 * 512, gt, ngt); copy_f32(I.convb, (float*)(ws + SM_CONVB), DEPTH * 512, gt, ngt);
    copy_f32(I.normw, (float*)(ws + SM_NORMW), DEPTH * 512, gt, ngt); copy_f32(I.skip, (float*)(ws + SM_SKIP), DEPTH * 512, gt, ngt);
}

#ifndef MK_RESID_NT
#define MK_RESID_NT 3
#endif
#if (MK_RESID_NT & 1) && !defined(EMU)
#define RESID_LD(T, p) NT_LOAD(T, p)
#else
#define RESID_LD(T, p) (*(const T*)(p))
#endif
#if (MK_RESID_NT & 2) && !defined(EMU)
#define RESID_ST(T, p, v) NT_STORE(T, p, v)
#else
#define RESID_ST(T, p, v) (*(T*)(p) = (v))
#endif
#ifndef MK_RESID_SPEC
#define MK_RESID_SPEC 1
#endif
#ifndef MK_RESID_INTER
#define MK_RESID_INTER 1
#endif
#ifndef RESID_AHEAD
#define RESID_AHEAD 1
#endif
#define RCOL(j) (8 * lane + 512 * ((j) >> 1) + 4 * ((j) & 1))
template <bool SRC32> DEV void resid_rows(const float* hsrc32, const bf16_t* HBr, const bf16_t* Y, float* out32, bf16_t* HBw, bf16_t* U, float* GI, float* GF, const float* gwt, const float* gb,
                                          const f32x4 (&A)[4], const f32x4 (&Bc)[4], const f32x4 (&Cc)[4], int rb, int rstr, int lane, bool final_out, bool has_y, bool has_next, bool gates, float yeps, bool u8, float* RS) {
    constexpr int NS = SRC32 ? 1 : RESID_AHEAD;
    f32x4 hn32[NS][2][4]; u32x4 hn16[NS][2][2], yn[NS][2][2];
#define RESID_LOAD(st, sl, r_) do { _Pragma("unroll") for (int pp = 0; pp < 2; ++pp) { const size_t o_ = (size_t)(r_) * 1024 + 8 * lane + 512 * pp; \
        if (SRC32) { hn32[st][sl][2 * pp] = *(const f32x4*)(hsrc32 + o_); hn32[st][sl][2 * pp + 1] = *(const f32x4*)(hsrc32 + o_ + 4); } else hn16[st][sl][pp] = RESID_LD(u32x4, HBr + o_); \
        if (has_y) yn[st][sl][pp] = RESID_LD(u32x4, Y + o_); } } while (0)
#define RESID_UNPK(dst, src_) do { const u32x4 t_ = (src_); dst[0] = (f32x4){bflo(t_.x), bfhi(t_.x), bflo(t_.y), bfhi(t_.y)}; dst[1] = (f32x4){bflo(t_.z), bfhi(t_.z), bflo(t_.w), bfhi(t_.w)}; } while (0)
#pragma unroll
    for (int st = 0; st < NS; ++st) { RESID_LOAD(st, 0, rb + rstr * st); RESID_LOAD(st, 1, rb + rstr * (8 + st)); }
    for (int k2 = 0; k2 < 8; k2 += NS) {
#pragma unroll
      for (int st = 0; st < NS; ++st) { const int k = k2 + st;
        f32x4 h[2][4]; u32x4 yw[2][2];
#pragma unroll
        for (int sl = 0; sl < 2; ++sl)
#pragma unroll
            for (int pp = 0; pp < 2; ++pp) { if (SRC32) { h[sl][2 * pp] = hn32[st][sl][2 * pp]; h[sl][2 * pp + 1] = hn32[st][sl][2 * pp + 1]; } else RESID_UNPK((&h[sl][2 * pp]), hn16[st][sl][pp]); yw[sl][pp] = yn[st][sl][pp]; }
        const int kn = k + NS < 8 ? k + NS : 7;
        RESID_LOAD(st, 0, rb + rstr * kn); RESID_LOAD(st, 1, rb + rstr * (8 + kn));
#pragma unroll
        for (int sl = 0; sl < 2; ++sl) { const int row = rb + rstr * (8 * sl + k);
            if (has_y) {
                f32x4 y[4]; float ss = 0.f;
#pragma unroll
                for (int pp = 0; pp < 2; ++pp) RESID_UNPK((&y[2 * pp]), yw[sl][pp]);
#pragma unroll
                for (int j = 0; j < 4; ++j) ss += (y[j][0] * y[j][0] + y[j][1] * y[j][1]) + (y[j][2] * y[j][2] + y[j][3] * y[j][3]);
                const float rs = rsqrtf(wave_sum(ss) * (1.0f / 1024.0f) + yeps);
#pragma unroll
                for (int j = 0; j < 4; ++j) { h[sl][j] = h[sl][j] + A[j] * y[j] * rs; if (final_out) *(f32x4*)(out32 + (size_t)row * 1024 + RCOL(j)) = h[sl][j]; }
                if (!final_out) {
#pragma unroll
                    for (int pp = 0; pp < 2; ++pp) { u32x4 w; w.x = pk2(h[sl][2 * pp][0], h[sl][2 * pp][1]); w.y = pk2(h[sl][2 * pp][2], h[sl][2 * pp][3]); w.z = pk2(h[sl][2 * pp + 1][0], h[sl][2 * pp + 1][1]); w.w = pk2(h[sl][2 * pp + 1][2], h[sl][2 * pp + 1][3]);
                        RESID_ST(u32x4, HBw + (size_t)row * 1024 + 8 * lane + 512 * pp, w); } }
            }
            if (has_next) {
                float ss = 0.f;
#pragma unroll
                for (int j = 0; j < 4; ++j) ss += (h[sl][j][0] * h[sl][j][0] + h[sl][j][1] * h[sl][j][1]) + (h[sl][j][2] * h[sl][j][2] + h[sl][j][3] * h[sl][j][3]);
                const float rs = rsqrtf(wave_sum(ss) * (1.0f / 1024.0f) + EPS);
#pragma unroll
                for (int j = 0; j < 4; ++j) h[sl][j] = h[sl][j] * rs * Bc[j] + Cc[j];
                if (u8) {
                    float am = 0.f;
#pragma unroll
                    for (int j = 0; j < 4; ++j) am = fmaxf(fmaxf(am, fmaxf(fabsf(h[sl][j][0]), fabsf(h[sl][j][1]))), fmaxf(fabsf(h[sl][j][2]), fabsf(h[sl][j][3])));
                    am = wave_max(am); const float inv = am > 0.f ? 127.0f * fast_rcp(am) : 0.f;
#pragma unroll
                    for (int pp = 0; pp < 2; ++pp) { mk_u32x2 w; w.x = pk_i8x4s(h[sl][2 * pp][0], h[sl][2 * pp][1], h[sl][2 * pp][2], h[sl][2 * pp][3], inv); w.y = pk_i8x4s(h[sl][2 * pp + 1][0], h[sl][2 * pp + 1][1], h[sl][2 * pp + 1][2], h[sl][2 * pp + 1][3], inv);
                        *(mk_u32x2*)((unsigned char*)U + u8_row(row) + 8 * lane + 512 * pp) = w; }
                    if (lane == 0) *(float*)((unsigned char*)U + u8_rs(row)) = am * (1.0f / 127.0f);
                } else {
#pragma unroll
                    for (int pp = 0; pp < 2; ++pp) { u32x4 w; w.x = pk2(h[sl][2 * pp][0], h[sl][2 * pp][1]); w.y = pk2(h[sl][2 * pp][2], h[sl][2 * pp][3]); w.z = pk2(h[sl][2 * pp + 1][0], h[sl][2 * pp + 1][1]); w.w = pk2(h[sl][2 * pp + 1][2], h[sl][2 * pp + 1][3]);
                        *(u32x4*)(U + (size_t)row * 1024 + 8 * lane + 512 * pp) = w; }
                }
                if (gates) {
#pragma unroll 2
                    for (int g = 0; g < 8; ++g) { float d = 0.f;
#pragma unroll
                        for (int j = 0; j < 4; ++j) { const f32x4 wv = *(const f32x4*)(gwt + g * 1024 + RCOL(j)); d += (h[sl][j][0] * wv[0] + h[sl][j][1] * wv[1]) + (h[sl][j][2] * wv[2] + h[sl][j][3] * wv[3]); }
                        d = wave_sum(d) + gb[g];
                        if (lane == 0) { if (g < 4) GI[(size_t)g * M + row] = d; else GF[(size_t)(g - 4) * M + row] = d; } }
                }
            }
        }
      }
    }
#undef RESID_LOAD
#undef RESID_UNPK
}
template <bool SRC32, bool HAS_Y, bool HAS_NEXT, bool U8, bool GATES>
DEV void resid_rows_t(const float* hsrc32, const bf16_t* HBr, const bf16_t* Y, float* out32, bf16_t* HBw, bf16_t* U, float* GI, float* GF, const float* gwt, const float* gb,
                      const f32x4 (&A)[4], const f32x4 (&Bc)[4], const f32x4 (&Cc)[4], int rb, int rstr, int lane, float yeps) {
    constexpr bool FINAL = !HAS_NEXT;
    constexpr int NS = SRC32 ? 1 : RESID_AHEAD;
    f32x4 hn32[NS][2][4]; u32x4 hn16[NS][2][2], yn[NS][2][2];
#define RT_LOAD(st, sl, r_) do { _Pragma("unroll") for (int pp = 0; pp < 2; ++pp) { const size_t o_ = (size_t)(r_) * 1024 + 8 * lane + 512 * pp; \
        if (SRC32) { hn32[st][sl][2 * pp] = *(const f32x4*)(hsrc32 + o_); hn32[st][sl][2 * pp + 1] = *(const f32x4*)(hsrc32 + o_ + 4); } else hn16[st][sl][pp] = RESID_LD(u32x4, HBr + o_); \
        if (HAS_Y) yn[st][sl][pp] = RESID_LD(u32x4, Y + o_); } } while (0)
#define RT_UNPK(dst, src_) do { const u32x4 t_ = (src_); dst[0] = (f32x4){bflo(t_.x), bfhi(t_.x), bflo(t_.y), bfhi(t_.y)}; dst[1] = (f32x4){bflo(t_.z), bfhi(t_.z), bflo(t_.w), bfhi(t_.w)}; } while (0)
#define RT_SUMSQ(v) (((v)[0][0] * (v)[0][0] + (v)[0][1] * (v)[0][1]) + ((v)[0][2] * (v)[0][2] + (v)[0][3] * (v)[0][3]) + ((v)[1][0] * (v)[1][0] + (v)[1][1] * (v)[1][1]) + ((v)[1][2] * (v)[1][2] + (v)[1][3] * (v)[1][3]) \
                   + ((v)[2][0] * (v)[2][0] + (v)[2][1] * (v)[2][1]) + ((v)[2][2] * (v)[2][2] + (v)[2][3] * (v)[2][3]) + ((v)[3][0] * (v)[3][0] + (v)[3][1] * (v)[3][1]) + ((v)[3][2] * (v)[3][2] + (v)[3][3] * (v)[3][3]))
#pragma unroll
    for (int st = 0; st < NS; ++st) { RT_LOAD(st, 0, rb + rstr * st); RT_LOAD(st, 1, rb + rstr * (8 + st)); }
    for (int k2 = 0; k2 < 8; k2 += NS) {
#pragma unroll
      for (int st = 0; st < NS; ++st) { const int k = k2 + st;
        f32x4 h[2][4], y[2][4]; const int row0 = rb + rstr * k, row1 = rb + rstr * (8 + k);
#pragma unroll
        for (int sl = 0; sl < 2; ++sl)
#pragma unroll
            for (int pp = 0; pp < 2; ++pp) { if (SRC32) { h[sl][2 * pp] = hn32[st][sl][2 * pp]; h[sl][2 * pp + 1] = hn32[st][sl][2 * pp + 1]; } else RT_UNPK((&h[sl][2 * pp]), hn16[st][sl][pp]); if (HAS_Y) RT_UNPK((&y[sl][2 * pp]), yn[st][sl][pp]); }
        const int kn = k + NS < 8 ? k + NS : 7;
        RT_LOAD(st, 0, rb + rstr * kn); RT_LOAD(st, 1, rb + rstr * (8 + kn));
        if (HAS_Y) {
            const float q0 = RT_SUMSQ(y[0]), q1 = RT_SUMSQ(y[1]);
            const float t0 = wave_sum(q0), t1 = wave_sum(q1);
            const float r0 = rsqrtf(t0 * (1.0f / 1024.0f) + yeps), r1 = rsqrtf(t1 * (1.0f / 1024.0f) + yeps);
#pragma unroll
            for (int j = 0; j < 4; ++j) { h[0][j] = h[0][j] + A[j] * y[0][j] * r0; h[1][j] = h[1][j] + A[j] * y[1][j] * r1; }
#pragma unroll
            for (int sl = 0; sl < 2; ++sl) { const int row = sl ? row1 : row0;
                if (FINAL) {
#pragma unroll
                    for (int j = 0; j < 4; ++j) *(f32x4*)(out32 + (size_t)row * 1024 + RCOL(j)) = h[sl][j];
                } else {
#pragma unroll
                    for (int pp = 0; pp < 2; ++pp) { u32x4 w; w.x = pk2(h[sl][2 * pp][0], h[sl][2 * pp][1]); w.y = pk2(h[sl][2 * pp][2], h[sl][2 * pp][3]); w.z = pk2(h[sl][2 * pp + 1][0], h[sl][2 * pp + 1][1]); w.w = pk2(h[sl][2 * pp + 1][2], h[sl][2 * pp + 1][3]);
                        RESID_ST(u32x4, HBw + (size_t)row * 1024 + 8 * lane + 512 * pp, w); } } }
        }
        if (HAS_NEXT) {
            const float q0 = RT_SUMSQ(h[0]), q1 = RT_SUMSQ(h[1]);
            const float t0 = wave_sum(q0), t1 = wave_sum(q1);
            const float r0 = rsqrtf(t0 * (1.0f / 1024.0f) + EPS), r1 = rsqrtf(t1 * (1.0f / 1024.0f) + EPS);
#pragma unroll
            for (int j = 0; j < 4; ++j) { h[0][j] = h[0][j] * r0 * Bc[j] + Cc[j]; h[1][j] = h[1][j] * r1 * Bc[j] + Cc[j]; }
            if (U8) {
                float a0 = 0.f, a1 = 0.f;
#pragma unroll
                for (int j = 0; j < 4; ++j) { a0 = fmaxf(fmaxf(a0, fmaxf(fabsf(h[0][j][0]), fabsf(h[0][j][1]))), fmaxf(fabsf(h[0][j][2]), fabsf(h[0][j][3]))); a1 = fmaxf(fmaxf(a1, fmaxf(fabsf(h[1][j][0]), fabsf(h[1][j][1]))), fmaxf(fabsf(h[1][j][2]), fabsf(h[1][j][3]))); }
                a0 = wave_max(a0); a1 = wave_max(a1);
                const float i0 = a0 > 0.f ? 127.0f * fast_rcp(a0) : 0.f, i1 = a1 > 0.f ? 127.0f * fast_rcp(a1) : 0.f;
#pragma unroll
                for (int sl = 0; sl < 2; ++sl) { const int row = sl ? row1 : row0; const float inv = sl ? i1 : i0;
#pragma unroll
                    for (int pp = 0; pp < 2; ++pp) { mk_u32x2 w; w.x = pk_i8x4s(h[sl][2 * pp][0], h[sl][2 * pp][1], h[sl][2 * pp][2], h[sl][2 * pp][3], inv); w.y = pk_i8x4s(h[sl][2 * pp + 1][0], h[sl][2 * pp + 1][1], h[sl][2 * pp + 1][2], h[sl][2 * pp + 1][3], inv);
                        *(mk_u32x2*)((unsigned char*)U + u8_row(row) + 8 * lane + 512 * pp) = w; }
                    *(float*)((unsigned char*)U + u8_rs(row)) = (sl ? a1 : a0) * (1.0f / 127.0f); }
            } else {
#pragma unroll
                for (int sl = 0; sl < 2; ++sl) { const int row = sl ? row1 : row0;
#pragma unroll
                    for (int pp = 0; pp < 2; ++pp) { u32x4 w; w.x = pk2(h[sl][2 * pp][0], h[sl][2 * pp][1]); w.y = pk2(h[sl][2 * pp][2], h[sl][2 * pp][3]); w.z = pk2(h[sl][2 * pp + 1][0], h[sl][2 * pp + 1][1]); w.w = pk2(h[sl][2 * pp + 1][2], h[sl][2 * pp + 1][3]);
                        *(u32x4*)(U + (size_t)row * 1024 + 8 * lane + 512 * pp) = w; } }
            }
            if (GATES) {
#pragma unroll 2
                for (int g = 0; g < 8; ++g) { float d0 = 0.f, d1 = 0.f;
#pragma unroll
                    for (int j = 0; j < 4; ++j) { const f32x4 wv = *(const f32x4*)(gwt + g * 1024 + RCOL(j));
                        d0 += (h[0][j][0] * wv[0] + h[0][j][1] * wv[1]) + (h[0][j][2] * wv[2] + h[0][j][3] * wv[3]); d1 += (h[1][j][0] * wv[0] + h[1][j][1] * wv[1]) + (h[1][j][2] * wv[2] + h[1][j][3] * wv[3]); }
                    d0 = wave_sum(d0) + gb[g]; d1 = wave_sum(d1) + gb[g];
                    float* gp = g < 4 ? GI + (size_t)g * M : GF + (size_t)(g - 4) * M; gp[row0] = d0; gp[row1] = d1; }
            }
        }
      }
    }
#undef RT_LOAD
#undef RT_UNPK
#undef RT_SUMSQ
}
DEV void phase_resid(Ctx& C, const float* hsrc32, bool final_out, const float* prew, const float* postw, const float* gateb, bool has_y, float wgt, int lpost, int spost, bool has_next, int lnext, int snext, bool gates, float yeps = EPS, bool u8 = false) {
    PHASE_LOCALS
    const float* mod = (const float*)(ws + WS_MOD);
    const bf16_t* Y = (const bf16_t*)(ws + WS_Y); bf16_t* U = (bf16_t*)(ws + WS_U); bf16_t* HB = (bf16_t*)(ws + WS_HB);
    const float* gwt = (const float*)(ws + WS_GWT) + (size_t)lnext * 8 * 1024; const float* gb = gateb + lnext * 8;
    float* GI = (float*)(ws + WS_GI); float* GF = (float*)(ws + WS_GF); float* RS = nullptr;
    const bool inter = MK_RESID_INTER && (ngw & 255) == 0 && (SEQ == 4096);
    const int nslab = inter ? M / 4096 : M / 16, sstep = inter ? (ngw >> 8) : ngw;
    for (int sidx = inter ? (gw >> 8) : gw; sidx < nslab; sidx += sstep) {
        const int rb = inter ? sidx * 4096 + (gw & 255) : sidx * 16, rstr = inter ? 256 : 1;
        const int b = rb / SEQ;
        f32x4 A[4], Bc[4], Cc[4];
#pragma unroll
        for (int j = 0; j < 4; ++j) { const int c = RCOL(j); A[j] = Bc[j] = Cc[j] = (f32x4){0.f, 0.f, 0.f, 0.f};
            if (has_y) { const float* mp = mod + ((size_t)lpost * BATCH + b) * 9216 + spost * 3072; A[j] = *(const f32x4*)(mp + 2048 + c) * *(const f32x4*)(postw + (lpost * 3 + spost) * 1024 + c) * wgt; }
            if (has_next) { const float* mn = mod + ((size_t)lnext * BATCH + b) * 9216 + snext * 3072; Bc[j] = *(const f32x4*)(prew + (lnext * 3 + snext) * 1024 + c) * (*(const f32x4*)(mn + 1024 + c) + 1.0f); Cc[j] = *(const f32x4*)(mn + c); } }
#define RR_T(S_, Y_, N_, U_, G_) resid_rows_t<S_, Y_, N_, U_, G_>(hsrc32, HB, Y, C.out, HB, U, GI, GF, gwt, gb, A, Bc, Cc, rb, rstr, lane, yeps)
        const bool fin = final_out && !has_next;
        if (MK_RESID_SPEC && hsrc32 && !has_y && has_next && !gates && !final_out) { if (u8) RR_T(true, false, true, true, false); else RR_T(true, false, true, false, false); }
        else if (MK_RESID_SPEC && hsrc32 && has_y && has_next && gates && !u8 && !final_out) RR_T(true, true, true, false, true);
        else if (MK_RESID_SPEC && !hsrc32 && has_y && has_next && !gates && !final_out) { if (u8) RR_T(false, true, true, true, false); else RR_T(false, true, true, false, false); }
        else if (MK_RESID_SPEC && !hsrc32 && has_y && has_next && gates && !u8 && !final_out) RR_T(false, true, true, false, true);
        else if (MK_RESID_SPEC && !hsrc32 && has_y && fin) RR_T(false, true, false, false, false);
        else if (hsrc32) resid_rows<true>(hsrc32, HB, Y, C.out, HB, U, GI, GF, gwt, gb, A, Bc, Cc, rb, rstr, lane, final_out, has_y, has_next, gates, yeps, u8, RS);
        else resid_rows<false>(hsrc32, HB, Y, C.out, HB, U, GI, GF, gwt, gb, A, Bc, Cc, rb, rstr, lane, final_out, has_y, has_next, gates, yeps, u8, RS);
#undef RR_T
    }
}

DEV int xcd_deal(int w, int k, int W, int N) { const int w8 = W >> 3; return (w / w8) * (N >> 3) + k * w8 + (w % w8); }
struct AttnBlk { bf16x8 k[4]; u32x2 v[8]; };
DEV int attn_nb(int rp, int r, int maxb) { const int n = rp == r ? 5 : (((rp - r) & 3) == 0 ? 2 : 1); return n < maxb ? n : maxb; }
DEV void attn_load(AttnBlk& B, const bf16_t* Kbh, const bf16_t* Vbh, int rp, int jk0, int qi, int g) {
    const bf16_t* kc = Kbh + (size_t)rp * 256 * 64; const bf16_t* vc = Vbh + (size_t)rp * 64 * 256;
#pragma unroll
    for (int kb = 0; kb < 2; ++kb) { int jr = jk0 + 16 * kb + qi; jr = jr < 0 ? 0 : jr; const bf16_t* kp = kc + (size_t)(jr >> 4) * 1024 + (jr & 15) * 32 + 8 * g;
        B.k[2 * kb] = *(const bf16x8*)kp; B.k[2 * kb + 1] = *(const bf16x8*)(kp + 512);
        int jt = (jk0 >> 4) + kb; jt = jt < 0 ? 0 : jt; const bf16_t* vp = vc + (size_t)jt * 1024 + qi * 16 + 4 * g;
#pragma unroll
        for (int dg = 0; dg < 4; ++dg) B.v[2 * dg + kb] = *(const u32x2*)(vp + dg * 256); }
}
DEV void attn_bounds(int rp, int jkb, int r, int jq, int g, unsigned& bmax, unsigned& bA, unsigned& bB, int& u0) {
    const int dr = r - rp, x0 = dr < 0 ? 1 : 0, n1 = ((128 - dr) >> 4) - x0 + 1, n2 = ((512 - dr) >> 4) - x0 + 1, n3 = ((2048 - dr) >> 4) - x0 + 1;
    const bool c16 = dr == 0, c4 = (dr & 3) == 0;
    const int nj = jq - x0 + 1;
    const int mx = c16 ? n3 : (c4 ? n2 : n1), a = c4 ? n1 : 0, b = c16 ? n2 : 0;
    bmax = (unsigned)(mx < nj ? mx : nj); bA = (unsigned)(a < nj ? a : nj); bB = (unsigned)(b < nj ? b : nj);
    u0 = jq - jkb - x0 - 4 * g;
}
DEV void attn_compute(const AttnBlk& B, int rp, int jk0, int r, int jq, int g, bf16x8 qf0, bf16x8 qf1, f32x4 (&o)[4], float& mrun, float& lrun) {
    f32x4 st[2];
#pragma unroll
    for (int kb = 0; kb < 2; ++kb) { st[kb] = mfma16(B.k[2 * kb], qf0, (f32x4){0.f, 0.f, 0.f, 0.f}); st[kb] = mfma16(B.k[2 * kb + 1], qf1, st[kb]); }
    float cm[2][4], s2[2][4]; float bm = NEGF;
    unsigned bmax, bA, bB; int u0; attn_bounds(rp, jk0, r, jq, g, bmax, bA, bB, u0);
#pragma unroll
    for (int kb = 0; kb < 2; ++kb)
#pragma unroll
        for (int i = 0; i < 4; ++i) { const unsigned u = (unsigned)(u0 - 16 * kb - i);
            cm[kb][i] = (u < bmax ? 1.f : 0.f) + (u < bA ? 1.f : 0.f) + (u < bB ? 1.f : 0.f); s2[kb][i] = u < bmax ? st[kb][i] : NEGF; bm = fmaxf(bm, s2[kb][i]); }
    bm = quad_max(bm);
    const float mnew = fmaxf(mrun, bm), alpha = fast_exp2(mrun - mnew); mrun = mnew;
    float p[2][4], ps = 0.f;
#pragma unroll
    for (int kb = 0; kb < 2; ++kb)
#pragma unroll
        for (int i = 0; i < 4; ++i) { p[kb][i] = cm[kb][i] * fast_exp2(s2[kb][i] - mnew); ps += p[kb][i]; }
    lrun = lrun * alpha + ps;
    const bf16x8 pf = mk8(pk2(p[0][0], p[0][1]), pk2(p[0][2], p[0][3]), pk2(p[1][0], p[1][1]), pk2(p[1][2], p[1][3]));
#pragma unroll
    for (int dg = 0; dg < 4; ++dg) o[dg] = mfma16(mk8(B.v[2 * dg].x, B.v[2 * dg].y, B.v[2 * dg + 1].x, B.v[2 * dg + 1].y), pf, o[dg] * alpha);
}
DEV void attn_compute2(const AttnBlk& B0, int rp0, int jk0, const AttnBlk& B1, int rp1, int jk1, int r, int jq, int g, bf16x8 qf0, bf16x8 qf1, f32x4 (&o)[4], float& mrun, float& lrun) {
    f32x4 st[2][2];
#pragma unroll
    for (int kb = 0; kb < 2; ++kb) { st[0][kb] = mfma16(B0.k[2 * kb], qf0, (f32x4){0.f, 0.f, 0.f, 0.f}); st[1][kb] = mfma16(B1.k[2 * kb], qf0, (f32x4){0.f, 0.f, 0.f, 0.f}); }
#pragma unroll
    for (int kb = 0; kb < 2; ++kb) { st[0][kb] = mfma16(B0.k[2 * kb + 1], qf1, st[0][kb]); st[1][kb] = mfma16(B1.k[2 * kb + 1], qf1, st[1][kb]); }
    float cm[2][2][4], s2[2][2][4]; float bm = NEGF;
#pragma unroll
    for (int bi = 0; bi < 2; ++bi) { const int rp = bi ? rp1 : rp0, jkb = bi ? jk1 : jk0;
        unsigned bmax, bA, bB; int u0; attn_bounds(rp, jkb, r, jq, g, bmax, bA, bB, u0);
#pragma unroll
        for (int kb = 0; kb < 2; ++kb)
#pragma unroll
            for (int i = 0; i < 4; ++i) { const unsigned u = (unsigned)(u0 - 16 * kb - i);
                cm[bi][kb][i] = (u < bmax ? 1.f : 0.f) + (u < bA ? 1.f : 0.f) + (u < bB ? 1.f : 0.f); s2[bi][kb][i] = u < bmax ? st[bi][kb][i] : NEGF; bm = fmaxf(bm, s2[bi][kb][i]); } }
    bm = quad_max(bm);
    const float mnew = fmaxf(mrun, bm), alpha = fast_exp2(mrun - mnew); mrun = mnew;
    float p[2][2][4], ps = 0.f;
#pragma unroll
    for (int bi = 0; bi < 2; ++bi)
#pragma unroll
        for (int kb = 0; kb < 2; ++kb)
#pragma unroll
            for (int i = 0; i < 4; ++i) { p[bi][kb][i] = cm[bi][kb][i] * fast_exp2(s2[bi][kb][i] - mnew); ps += p[bi][kb][i]; }
    lrun = lrun * alpha + ps;
    const bf16x8 pf0 = mk8(pk2(p[0][0][0], p[0][0][1]), pk2(p[0][0][2], p[0][0][3]), pk2(p[0][1][0], p[0][1][1]), pk2(p[0][1][2], p[0][1][3]));
    const bf16x8 pf1 = mk8(pk2(p[1][0][0], p[1][0][1]), pk2(p[1][0][2], p[1][0][3]), pk2(p[1][1][0], p[1][1][1]), pk2(p[1][1][2], p[1][1][3]));
#pragma unroll
    for (int dg = 0; dg < 4; ++dg) { o[dg] = mfma16(mk8(B0.v[2 * dg].x, B0.v[2 * dg].y, B0.v[2 * dg + 1].x, B0.v[2 * dg + 1].y), pf0, o[dg] * alpha);
        o[dg] = mfma16(mk8(B1.v[2 * dg].x, B1.v[2 * dg].y, B1.v[2 * dg + 1].x, B1.v[2 * dg + 1].y), pf1, o[dg]); }
}
#define ATTN_GEN(orp, ojk) do { ++gblk; if (grp < 16 && gblk >= attn_nb(grp, r, maxb)) { ++grp; gblk = 0; } const bool _v = grp < 16; orp = _v ? grp : 0; ojk = _v ? j0 + 16 - 32 * (gblk + 1) : j0 - 16; } while (0)
DEV void phase_attn(Ctx& C) {
    PHASE_LOCALS
    const bf16_t* Q16 = (const bf16_t*)(ws + WS_Q16); const bf16_t* K16 = (const bf16_t*)(ws + WS_K16); const bf16_t* VT16 = (const bf16_t*)(ws + WS_VT16);
    bf16_t* MIX = (bf16_t*)(ws + WS_U);
    const int qi = lane & 15, g = lane >> 4;
    const bool xdeal = ((ngw & 7) == 0) && ((NBH * 256) % ngw == 0);
    for (int kit = 0, u0 = gw; u0 < NBH * 256; ++kit, u0 += ngw) {
        const int u = xdeal ? xcd_deal(gw, kit, ngw, NBH * 256) : u0;
        const int bh = u >> 8, r = (u >> 4) & 15, jb = ((u & 15) + 5 * kit) & 15, j0 = 16 * jb, b = bh >> 2, hd = bh & 3;
        const bf16_t* qp = Q16 + ((size_t)bh * 16 + r) * 256 * 64 + (size_t)jb * 1024 + qi * 32 + 8 * g;
        const bf16x8 qf0 = *(const bf16x8*)qp, qf1 = *(const bf16x8*)(qp + 512);
        const bf16_t* Kbh = K16 + (size_t)bh * 16 * 256 * 64; const bf16_t* Vbh = VT16 + (size_t)bh * 16 * 64 * 256;
        f32x4 o[4];
#pragma unroll
        for (int dg = 0; dg < 4; ++dg) o[dg] = (f32x4){0.f, 0.f, 0.f, 0.f};
        float mrun = NEGF, lrun = 0.f;
        const int jq = j0 + qi, maxb = (j0 + 47) >> 5;
        const int T = attn_nb(r, r, maxb) + 3 * attn_nb((r + 4) & 15, r, maxb) + 12;
        int grp = 0, gblk = -1;
        for (int t = 0; t < T; t += 4) {
            AttnBlk b0, b1, b2, b3; int rp0, jk0, rp1, jk1, rp2, jk2, rp3, jk3;
            ATTN_GEN(rp0, jk0); attn_load(b0, Kbh, Vbh, rp0, jk0, qi, g);
            ATTN_GEN(rp1, jk1); attn_load(b1, Kbh, Vbh, rp1, jk1, qi, g);
            ATTN_GEN(rp2, jk2); attn_load(b2, Kbh, Vbh, rp2, jk2, qi, g);
            ATTN_GEN(rp3, jk3); attn_load(b3, Kbh, Vbh, rp3, jk3, qi, g);
            if (t + 1 < T) attn_compute2(b0, rp0, jk0, b1, rp1, jk1, r, jq, g, qf0, qf1, o, mrun, lrun); else attn_compute(b0, rp0, jk0, r, jq, g, qf0, qf1, o, mrun, lrun);
            if (t + 3 < T) attn_compute2(b2, rp2, jk2, b3, rp3, jk3, r, jq, g, qf0, qf1, o, mrun, lrun); else if (t + 2 < T) attn_compute(b2, rp2, jk2, r, jq, g, qf0, qf1, o, mrun, lrun);
        }
        const float linv = fast_rcp(quad_sum(lrun));
        const int s = 16 * jq + r; bf16_t* op = MIX + ((size_t)b * SEQ + s) * 1024 + 64 * hd + 4 * g;
#pragma unroll
        for (int dg = 0; dg < 4; ++dg) { const f32x4 v = o[dg] * linv; u32x2 w; w.x = pk2(v[0], v[1]); w.y = pk2(v[2], v[3]); *(u32x2*)(op + 16 * dg) = w; }
    }
}

DEV void phase_pool(Ctx& C, int l) {
    PHASE_LOCALS
    const bf16_t* PIN = (const bf16_t*)(ws + WS_PIN); const bf16_t* pwt = (const bf16_t*)(ws + WS_PWT) + (size_t)l * 4 * 64 * 64;
    const float* psc = (const float*)(ws + SM_POOLS) + l * 256; bf16_t* MIX = (bf16_t*)(ws + WS_U);
    const int ri = lane & 15, q = lane >> 4;
    for (int u = gw; u < M / 16; u += ngw) {
        const int row = 16 * u + ri, s = row & (SEQ - 1);
#pragma unroll
        for (int g = 0; g < 4; ++g) {
            const int w = 2 << g, cnt = (s + 1) < w ? (s + 1) : w; const float inv = 1.0f / (float)cnt;
            bf16x8 df[2];
#pragma unroll
            for (int ks = 0; ks < 2; ++ks) { const bf16_t* pp = PIN + (size_t)row * 256 + 64 * g + 32 * ks + 8 * q;
                float sum[8];
#pragma unroll
                for (int e = 0; e < 8; ++e) sum[e] = 0.f;
                u32x4 cur = (u32x4){0u, 0u, 0u, 0u};
                for (int k = 0; k < cnt; ++k) { const u32x4 v = *(const u32x4*)(pp - (size_t)k * 256); if (k == 0) cur = v;
                    sum[0] += bflo(v.x); sum[1] += bfhi(v.x); sum[2] += bflo(v.y); sum[3] += bfhi(v.y); sum[4] += bflo(v.z); sum[5] += bfhi(v.z); sum[6] += bflo(v.w); sum[7] += bfhi(v.w); }
                df[ks] = mk8(pk2(sum[0] * inv - bflo(cur.x), sum[1] * inv - bfhi(cur.x)), pk2(sum[2] * inv - bflo(cur.y), sum[3] * inv - bfhi(cur.y)),
                             pk2(sum[4] * inv - bflo(cur.z), sum[5] * inv - bfhi(cur.z)), pk2(sum[6] * inv - bflo(cur.w), sum[7] * inv - bfhi(cur.w))); }
#pragma unroll
            for (int eb = 0; eb < 4; ++eb) { const bf16_t* wp = pwt + ((size_t)g * 64 + 16 * eb + ri) * 64 + 8 * q;
                f32x4 acc = mfma16(*(const bf16x8*)wp, df[0], (f32x4){0.f, 0.f, 0.f, 0.f}); acc = mfma16(*(const bf16x8*)(wp + 32), df[1], acc);
                const f32x4 sc = *(const f32x4*)(psc + 64 * g + 16 * eb + 4 * q); acc = acc * sc;
                u32x2 wv; wv.x = pk2(acc[0], acc[1]); wv.y = pk2(acc[2], acc[3]);
                *(u32x2*)(MIX + (size_t)row * 1024 + 256 + 64 * g + 16 * eb + 4 * q) = wv; }
        }
    }
}

constexpr int XC_STR = 136, KT_STR = 72;
constexpr int LA_XC = 0, LA_XM = 64 * XC_STR * 2, LA_KT = 2 * 64 * XC_STR * 2, LA_VT = LA_KT + 128 * KT_STR * 2, LA_WA = LA_VT + 128 * KT_STR * 2;
#define MA_PREFETCH(uu) do { const int bh_ = (uu) >> 6, c_ = (uu) & 63, b_ = bh_ >> 2, hd_ = bh_ & 3; \
        _Pragma("unroll") for (int t = 0; t < 4; ++t) { int sp_ = 64 * c_ + (tid >> 3) - 3 + t; sp_ = sp_ < 0 ? 0 : sp_; \
            const bf16_t* xp_ = XM + ((size_t)b_ * SEQ + sp_) * 512 + 128 * hd_ + (tid & 7) * 16; pre[2 * t] = *(const u32x4*)xp_; pre[2 * t + 1] = *(const u32x4*)(xp_ + 8); } \
        pgf = GF[(size_t)hd_ * M + (size_t)b_ * SEQ + 64 * c_ + lane]; pgi = GI[(size_t)hd_ * M + (size_t)b_ * SEQ + 64 * c_ + lane]; } while (0)
DEV void phase_mlstm_a(Ctx& C, int l) {
    PHASE_LOCALS
    const bf16_t* XM = (const bf16_t*)(ws + WS_XM); bf16_t* XC = (bf16_t*)(ws + WS_XC);
    bf16_t* MQ = (bf16_t*)(ws + WS_MQ); bf16_t* MK = (bf16_t*)(ws + WS_MK); bf16_t* MVT = (bf16_t*)(ws + WS_MVT);
    bf16_t* DCT = (bf16_t*)(ws + WS_DCT); float* DN = (float*)(ws + WS_DN);
    const float* GI = (const float*)(ws + WS_GI); const float* GF = (const float*)(ws + WS_GF);
    float* BCUM = (float*)(ws + WS_BCUM); float* BL = (float*)(ws + WS_BL); float* AM = (float*)(ws + WS_AM);
    const bf16_t* wqt = (const bf16_t*)(ws + WS_WQT) + (size_t)l * 3 * 4 * 128 * 128;
    const float* cw = (const float*)(ws + SM_CONVW) + l * 4 * 512; const float* cb = (const float*)(ws + SM_CONVB) + l * 512;
    LAS bf16_t* xcL = (LAS bf16_t*)(C.lds + LA_XC); LAS bf16_t* xmL = (LAS bf16_t*)(C.lds + LA_XM); LAS bf16_t* kT = (LAS bf16_t*)(C.lds + LA_KT); LAS bf16_t* vT = (LAS bf16_t*)(C.lds + LA_VT); LAS float* waL = (LAS float*)(C.lds + LA_WA);
    const int w = wave, ri = lane & 15, g = lane >> 4;
    const int NU = NBH * NCH;
    u32x4 pre[8]; float pgf, pgi; bf16x8 wf[3][4]; int hd_prev = -1;
    const bool xdeal = (NU % C.nblk) == 0; const int KU = NU / C.nblk;
    if (C.blk < NU) MA_PREFETCH(xdeal ? vblk * KU : C.blk);
    for (int kit = 0, u0 = C.blk; u0 < NU; ++kit, u0 += C.nblk) {
        const int u = xdeal ? vblk * KU + kit : u0;
        const int bh = u >> 6, c = u & 63, b = bh >> 2, hd = bh & 3, s0 = 64 * c; const size_t row0 = (size_t)b * SEQ + s0;
        { const int lr = tid >> 3, ch = 128 * hd + (tid & 7) * 16;
          float a[16];
#pragma unroll
          for (int e = 0; e < 16; ++e) a[e] = cb[ch + e];
#pragma unroll
          for (int t = 0; t < 4; ++t) { const float on = (s0 + lr - 3 + t) >= 0 ? 1.0f : 0.0f; const float* wp = cw + t * 512 + ch;
              const unsigned vv[8] = {pre[2 * t].x, pre[2 * t].y, pre[2 * t].z, pre[2 * t].w, pre[2 * t + 1].x, pre[2 * t + 1].y, pre[2 * t + 1].z, pre[2 * t + 1].w};
#pragma unroll
              for (int e = 0; e < 8; ++e) { a[2 * e] += on * wp[2 * e] * bflo(vv[e]); a[2 * e + 1] += on * wp[2 * e + 1] * bfhi(vv[e]); } }
          unsigned pw[8];
#pragma unroll
          for (int e = 0; e < 8; ++e) pw[e] = pk2(a[2 * e] * sigmoid_f(a[2 * e]), a[2 * e + 1] * sigmoid_f(a[2 * e + 1]));
          u32x4 o0, o1; o0.x = pw[0]; o0.y = pw[1]; o0.z = pw[2]; o0.w = pw[3]; o1.x = pw[4]; o1.y = pw[5]; o1.z = pw[6]; o1.w = pw[7];
          *(LAS u32x4*)(xcL + lr * XC_STR + (tid & 7) * 16) = o0; *(LAS u32x4*)(xcL + lr * XC_STR + (tid & 7) * 16 + 8) = o1;
          *(LAS u32x4*)(xmL + lr * XC_STR + (tid & 7) * 16) = pre[6]; *(LAS u32x4*)(xmL + lr * XC_STR + (tid & 7) * 16 + 8) = pre[7];
          bf16_t* gp = XC + (row0 + lr) * 512 + ch; *(u32x4*)gp = o0; *(u32x4*)(gp + 8) = o1; }
        if (w == 0) {
            const float f = pgf, ip = pgi;
            const float lf = fminf(f, 0.f) - __logf(1.0f + __expf(-fabsf(f)));
            const float bc = wave_prefix_sum(lf);
            const float blast = lane63(bc), a = blast - bc + ip;
            const float amax = wave_max(a);
            waL[lane] = __expf(a - amax); BCUM[(size_t)hd * M + row0 + lane] = bc;
            if (lane == 0) { BL[u] = blast; AM[u] = amax; }
        }
        if (hd != hd_prev) {
#pragma unroll
            for (int which = 0; which < 3; ++which) { const bf16_t* wp = wqt + (((size_t)which * 4 + hd) * 128 + 16 * w + ri) * 128 + 8 * g;
#pragma unroll
                for (int ks = 0; ks < 4; ++ks) wf[which][ks] = *(const bf16x8*)(wp + 32 * ks); }
            hd_prev = hd; }
        __syncthreads();
        { const int un = xdeal ? (kit + 1 < KU ? u + 1 : u) : (u + C.nblk < NU ? u + C.nblk : u); MA_PREFETCH(un); }
#pragma unroll
        for (int which = 0; which < 3; ++which) {
#pragma unroll
            for (int rb = 0; rb < 4; ++rb) {
                bf16x8 xf[4];
#pragma unroll
                for (int ks = 0; ks < 4; ++ks) xf[ks] = *(const LAS bf16x8*)((which == 2 ? xmL : xcL) + (16 * rb + ri) * XC_STR + 32 * ks + 8 * g);
                if (which <= 1) {
                    f32x4 at = (f32x4){0.f, 0.f, 0.f, 0.f};
#pragma unroll
                    for (int ks = 0; ks < 4; ++ks) at = mfma16(wf[which][ks], xf[ks], at);
                    if (which == 0) at = at * 0.08838834764831845f;
                    u32x2 o; o.x = pk2(at[0], at[1]); o.y = pk2(at[2], at[3]);
                    *(u32x2*)((which == 0 ? MQ : MK) + (((size_t)u * 4 + rb) * 4 + (w >> 1)) * 512 + ri * 32 + (2 * (w & 1) + (g >> 1)) * 8 + 4 * (g & 1)) = o; }
                if (which >= 1) {
                    f32x4 an = (f32x4){0.f, 0.f, 0.f, 0.f};
#pragma unroll
                    for (int ks = 0; ks < 4; ++ks) an = mfma16(xf[ks], wf[which][ks], an);
                    if (which == 1) { an = an * *(const LAS f32x4*)(waL + 16 * rb + 4 * g); }
                    u32x2 o; o.x = pk2(an[0], an[1]); o.y = pk2(an[2], an[3]);
                    *(LAS u32x2*)((which == 1 ? kT : vT) + (16 * w + ri) * KT_STR + 16 * rb + 4 * g) = o;
                    if (which == 2) *(u32x2*)(MVT + (((size_t)u * 8 + w) * 2 + (rb >> 1)) * 512 + ri * 32 + g * 8 + (rb & 1) * 4) = o; }
            }
        }
        __syncthreads();
        { bf16x8 af[2];
#pragma unroll
          for (int ls = 0; ls < 2; ++ls) af[ls] = *(const LAS bf16x8*)(kT + (16 * w + ri) * KT_STR + 32 * ls + 8 * g);
          float dn = 0.f;
#pragma unroll
          for (int ls = 0; ls < 2; ++ls) { const u32x4 t = __builtin_bit_cast(u32x4, af[ls]); dn += (bflo(t.x) + bfhi(t.x)) + (bflo(t.y) + bfhi(t.y)) + (bflo(t.z) + bfhi(t.z)) + (bflo(t.w) + bfhi(t.w)); }
          dn = quad_sum(dn);
          if (g == 0) DN[(size_t)u * 128 + 16 * w + ri] = dn;
#pragma unroll
          for (int eb = 0; eb < 8; ++eb) { f32x4 acc = (f32x4){0.f, 0.f, 0.f, 0.f};
#pragma unroll
              for (int ls = 0; ls < 2; ++ls) acc = mfma16(af[ls], *(const LAS bf16x8*)(vT + (16 * eb + ri) * KT_STR + 32 * ls + 8 * g), acc);
              { u32x2 ov; ov.x = pk2(acc[0], acc[1]); ov.y = pk2(acc[2], acc[3]); *(u32x2*)(DCT + (((size_t)u * 8 + eb) * 4 + (w >> 1)) * 512 + ri * 32 + (2 * (w & 1) + (g >> 1)) * 8 + 4 * (g & 1)) = ov; } } }
        __syncthreads();
    }
}
#undef MA_PREFETCH

DEV void phase_scan(Ctx& C) {
    PHASE_LOCALS
    bf16_t* DCT = (bf16_t*)(ws + WS_DCT); float* DN = (float*)(ws + WS_DN);
    const float* BL = (const float*)(ws + WS_BL); const float* AM = (const float*)(ws + WS_AM); float* MP = (float*)(ws + WS_MP);
    constexpr int GRP = 16;
    for (int it = vblk * 512 + tid; it < NBH * 4096; it += C.nblk * 512) {
        const int bh = it >> 12, rem = it & 4095, e = ((rem >> 9) << 4) + ((rem >> 3) & 15), d = (((rem >> 7) & 3) << 5) + (((rem >> 1) & 3) << 3) + ((rem & 1) << 2);
        f32x4 Cs = (f32x4){0.f, 0.f, 0.f, 0.f}, Ns = (f32x4){0.f, 0.f, 0.f, 0.f}; float m = 0.f;
        for (int c0 = 0; c0 < NCH; c0 += GRP) {
            u32x2 dw[GRP]; f32x4 dnv[GRP]; float bl[GRP], am[GRP];
#pragma unroll
            for (int k = 0; k < GRP; ++k) { const int u = bh * NCH + c0 + k; dw[k] = *(const u32x2*)(DCT + (size_t)u * 16384 + rem * 4); bl[k] = BL[u]; am[k] = AM[u];
                dnv[k] = e == 0 ? *(const f32x4*)(DN + (size_t)u * 128 + d) : (f32x4){0.f, 0.f, 0.f, 0.f}; }
#pragma unroll
            for (int k = 0; k < GRP; ++k) { const int u = bh * NCH + c0 + k;
                const float mn = fmaxf(bl[k] + m, am[k]), decay = __expf(bl[k] + m - mn), inj = __expf(am[k] - mn);
                const f32x4 dc = (f32x4){bflo(dw[k].x), bfhi(dw[k].x), bflo(dw[k].y), bfhi(dw[k].y)};
                { u32x2 cw2; cw2.x = pk2(Cs[0], Cs[1]); cw2.y = pk2(Cs[2], Cs[3]); *(u32x2*)(DCT + (size_t)u * 16384 + rem * 4) = cw2; } Cs = Cs * decay + dc * inj;
                if (e == 0) { *(f32x4*)(DN + (size_t)u * 128 + d) = Ns; Ns = Ns * decay + dnv[k] * inj; }
                if (rem == 0) MP[u] = m;
                m = mn; }
        }
    }
}

DEV void phase_mlstm_c(Ctx& C, int l) {
    PHASE_LOCALS
    const bf16_t* MQ = (const bf16_t*)(ws + WS_MQ); const bf16_t* MK = (const bf16_t*)(ws + WS_MK); const bf16_t* MVT = (const bf16_t*)(ws + WS_MVT);
    const bf16_t* OG = (const bf16_t*)(ws + WS_OG); const bf16_t* XC = (const bf16_t*)(ws + WS_XC); bf16_t* MIX = (bf16_t*)(ws + WS_U);
    const bf16_t* CPT = (const bf16_t*)(ws + WS_DCT); const float* NP = (const float*)(ws + WS_DN);
    const float* GI = (const float*)(ws + WS_GI); const float* BCUM = (const float*)(ws + WS_BCUM); const float* MP = (const float*)(ws + WS_MP);
    const float* nw = (const float*)(ws + SM_NORMW) + l * 512; const float* sk = (const float*)(ws + SM_SKIP) + l * 512;
    const int ri = lane & 15, g = lane >> 4;
    const bool xdeal = ((ngw & 7) == 0) && ((NBH * NCH * 4) % ngw == 0);
    for (int kit = 0, w0 = gw; w0 < NBH * NCH * 4; ++kit, w0 += ngw) {
        const int wu = xdeal ? xcd_deal(gw, kit, ngw, NBH * NCH * 4) : w0;
        const int u = wu >> 2, lb = wu & 3, bh = u >> 6, c = u & 63, b = bh >> 2, hd = bh & 3; const size_t row0 = (size_t)b * SEQ + 64 * c;
        const int lrow = 16 * lb + ri; const size_t grow = row0 + lrow;
        const float bl_l = BCUM[(size_t)hd * M + grow], mprev = MP[u];
        f32x4 bs[4], is[4]; bf16x8 qf[4], kf[4][4]; f32x4 n0[4], n1[4];
#pragma unroll
        for (int sb = 0; sb < 4; ++sb) { bs[sb] = *(const f32x4*)(BCUM + (size_t)hd * M + row0 + 16 * sb + 4 * g); is[sb] = *(const f32x4*)(GI + (size_t)hd * M + row0 + 16 * sb + 4 * g); }
#pragma unroll
        for (int ks = 0; ks < 4; ++ks) { qf[ks] = *(const bf16x8*)(MQ + (((size_t)u * 4 + lb) * 4 + ks) * 512 + ri * 32 + g * 8);
            n0[ks] = *(const f32x4*)(NP + (size_t)u * 128 + 32 * ks + 8 * g); n1[ks] = *(const f32x4*)(NP + (size_t)u * 128 + 32 * ks + 8 * g + 4); }
#pragma unroll
        for (int sb = 0; sb < 4; ++sb)
#pragma unroll
            for (int ks = 0; ks < 4; ++ks) kf[sb][ks] = *(const bf16x8*)(MK + (((size_t)u * 4 + sb) * 4 + ks) * 512 + ri * 32 + g * 8);
        SCHED_FENCE();
        float ld[4][4]; float mx = NEGF;
#pragma unroll
        for (int sb = 0; sb < 4; ++sb)
#pragma unroll
            for (int i = 0; i < 4; ++i) { ld[sb][i] = (16 * sb + 4 * g + i <= lrow) ? bl_l - bs[sb][i] + is[sb][i] : NEGF; mx = fmaxf(mx, ld[sb][i]); }
        mx = quad_max(mx);
        const float mt = fmaxf(bl_l + mprev, mx), iw = __expf(bl_l + mprev - mt);
        float sw[4][4]; float dsum = 0.f;
#pragma unroll
        for (int sb = 0; sb < 4; ++sb) { f32x4 st = (f32x4){0.f, 0.f, 0.f, 0.f};
#pragma unroll
            for (int ks = 0; ks < 4; ++ks) st = mfma16(kf[sb][ks], qf[ks], st);
#pragma unroll
            for (int i = 0; i < 4; ++i) { sw[sb][i] = st[i] * __expf(ld[sb][i] - mt); dsum += sw[sb][i]; } }
        float dq = 0.f; bf16x8 qs[4];
#pragma unroll
        for (int ks = 0; ks < 4; ++ks) { const u32x4 t = __builtin_bit_cast(u32x4, qf[ks]);
            const f32x4 q0 = (f32x4){bflo(t.x), bfhi(t.x), bflo(t.y), bfhi(t.y)}, q1 = (f32x4){bflo(t.z), bfhi(t.z), bflo(t.w), bfhi(t.w)};
            dq += (q0[0] * n0[ks][0] + q0[1] * n0[ks][1]) + (q0[2] * n0[ks][2] + q0[3] * n0[ks][3]) + (q1[0] * n1[ks][0] + q1[1] * n1[ks][1]) + (q1[2] * n1[ks][2] + q1[3] * n1[ks][3]);
            qs[ks] = pack8(q0 * iw, q1 * iw); }
        dq = quad_sum(dq); dsum = quad_sum(dsum);
        const float den = iw * dq + dsum, hs = fast_rcp(fmaxf(fabsf(den), __expf(-mt)));
        const bf16x8 pf0 = mk8(pk2(sw[0][0], sw[0][1]), pk2(sw[0][2], sw[0][3]), pk2(sw[1][0], sw[1][1]), pk2(sw[1][2], sw[1][3]));
        const bf16x8 pf1 = mk8(pk2(sw[2][0], sw[2][1]), pk2(sw[2][2], sw[2][3]), pk2(sw[3][0], sw[3][1]), pk2(sw[3][2], sw[3][3]));
        f32x4 hv[8], sx[8]; float ss = 0.f;
        bf16x8 cf[2][4], vf[2][2]; u32x2 ogw[2], xcw[2]; f32x4 nwv[2], skv[2];
#define MC_LOADS(eb_, bu_) do { const int col_ = 128 * hd + 16 * (eb_) + 4 * g; \
            const bf16_t* cp = CPT + ((size_t)u * 8 + (eb_)) * 2048 + ri * 32 + g * 8; const bf16_t* vp = MVT + ((size_t)u * 8 + (eb_)) * 1024 + ri * 32 + g * 8; \
            _Pragma("unroll") for (int ks = 0; ks < 4; ++ks) cf[bu_][ks] = *(const bf16x8*)(cp + 512 * ks); \
            vf[bu_][0] = *(const bf16x8*)vp; vf[bu_][1] = *(const bf16x8*)(vp + 512); \
            ogw[bu_] = *(const u32x2*)(OG + grow * 512 + col_); xcw[bu_] = *(const u32x2*)(XC + grow * 512 + col_); \
            nwv[bu_] = *(const f32x4*)(nw + col_); skv[bu_] = *(const f32x4*)(sk + col_); } while (0)
        MC_LOADS(0, 0);
#pragma unroll
        for (int eb = 0; eb < 8; ++eb) { const int bu = eb & 1;
            if (eb + 1 < 8) MC_LOADS(eb + 1, bu ^ 1);
            SCHED_FENCE();
            f32x4 acc = (f32x4){0.f, 0.f, 0.f, 0.f};
#pragma unroll
            for (int ks = 0; ks < 4; ++ks) acc = mfma16(cf[bu][ks], qs[ks], acc);
            acc = mfma16(vf[bu][0], pf0, acc); acc = mfma16(vf[bu][1], pf1, acc);
            acc = acc * hs; acc[0] *= sigmoid_f(bflo(ogw[bu].x)); acc[1] *= sigmoid_f(bfhi(ogw[bu].x)); acc[2] *= sigmoid_f(bflo(ogw[bu].y)); acc[3] *= sigmoid_f(bfhi(ogw[bu].y));
            ss += (acc[0] * acc[0] + acc[1] * acc[1]) + (acc[2] * acc[2] + acc[3] * acc[3]);
            hv[eb] = acc * nwv[bu];
            sx[eb] = skv[bu] * (f32x4){bflo(xcw[bu].x), bfhi(xcw[bu].x), bflo(xcw[bu].y), bfhi(xcw[bu].y)};
            SCHED_FENCE();
        }
#undef MC_LOADS
        const float rstd = rsqrtf(quad_sum(ss) * (1.0f / 128.0f) + EPS);
#pragma unroll
        for (int eb = 0; eb < 8; ++eb) { const int col = 128 * hd + 16 * eb + 4 * g;
            const f32x4 o = hv[eb] * rstd + sx[eb];
            u32x2 wv; wv.x = pk2(o[0], o[1]); wv.y = pk2(o[2], o[3]); *(u32x2*)(MIX + grow * 1024 + 512 + col) = wv; }
    }
}
#ifndef EMU
constexpr int LDS_BYTES = 147456, MISC_OFF = 131072 + 320, CW_BAR = 4096;
constexpr int N_PHASES = 2 + 4 * 12;
#ifndef PHM
#define PHM 0xffff
#endif
#ifndef PG8_SP2
#define PG8_SP2 true
#endif
#ifndef PG8_ALIGN
#define PG8_ALIGN true
#endif
#ifndef REPM
#define REPM 0
#endif
#ifndef MK_LOCALBAR
#define MK_LOCALBAR 1
#endif
#define NREP(bit) (((REPM) & (bit)) ? 2 : 1)
struct Params { const float* in[18]; float* out; unsigned char* ws; int ph_lo, ph_hi; };
__global__ void __launch_bounds__(512, 2) mk_fwd(Params p) {
    extern __shared__ __attribute__((aligned(16))) unsigned char lds_raw[];
    Ctx C; C.lds = (LAS unsigned char*)lds_raw; C.wv = __builtin_amdgcn_readfirstlane((int)threadIdx.x >> 6); C.blk = blockIdx.x; C.nblk = gridDim.x; C.out = p.out; C.ws = p.ws;
    C.vb = (C.nblk & 7) ? C.blk : (C.blk & 7) * (C.nblk >> 3) + (C.blk >> 3);
    volatile LAS unsigned* MISC = (volatile LAS unsigned*)(C.lds + MISC_OFF);
    if (threadIdx.x < 32) MISC[threadIdx.x] = 0u;
    __syncthreads();
    const int lo = p.ph_lo, hi = p.ph_hi;
    unsigned* barw = (unsigned*)(p.ws + WS_CTL) + CW_BAR;
    XcdBarrier bar; bar.wv = C.wv; bar.bar = barw; bar.x = 0; bar.st = MISC + 8;
    if (hi - lo > 1) { bar.x = xb_xcc_id(); if (C.wv == 0 && mk_lane_id() == 0) MISC[10] = xb_add(&barw[XB_XCNT(bar.x)], 1u); }
    int ph = 0;
#define RUN (ph >= lo && ph < hi)
#define SEAM do { if (ph >= lo && ph + 1 < hi) { xcd_barrier(bar); if (REPM & 16384) xcd_barrier(bar); } ++ph; } while (0)
    const int G = (int)gridDim.x, bx = (int)blockIdx.x;
    unsigned char* ws = p.ws;
    const float* smpre = (const float*)(ws + SM_PRE); const float* smpost = (const float*)(ws + SM_POST); const float* smgb = (const float*)(ws + SM_GATEB);
    if (RUN && (PHM & 1)) { for (int rep = 0; rep < NREP(1); ++rep) phase_mod(C, p.in[I_C], p.in[I_ADAW], p.in[I_ADAB]); }
    SEAM;
    if (RUN) { if (PHM & 2) { const CvtIn I{p.in[I_UP], p.in[I_DOWN], p.in[I_MIXIN], p.in[I_MIXOUT], p.in[I_POOLW], p.in[I_QKVW], p.in[I_PRE], p.in[I_POST], p.in[I_GATEB], p.in[I_POOLS], p.in[I_CONVW], p.in[I_CONVB], p.in[I_NORMW], p.in[I_SKIP]}; for (int rep = 0; rep < NREP(2); ++rep) phase_convert(C, I); }
        if (PHM & 4) phase_resid(C, p.in[I_X], false, p.in[I_PRE], p.in[I_POST], p.in[I_GATEB], false, 0.f, 0, 0, true, 0, 0, false, EPS, (MK_I8MASK & 1) != 0); }
    SEAM;
    bool uni = false; int cg = bx;
#if MK_LOCALBAR
    if (lo == 0 && hi > 2) {
        if (C.wv == 0 && mk_lane_id() == 0) { unsigned ok = ((G & 7) == 0 && bar.x < 8u) ? 1u : 0u;
            for (unsigned j = 0; j < 16; ++j) { const unsigned c = xb_ld(&barw[XB_XCNT(j)]); if (c != (j < 8u ? (unsigned)(G >> 3) : 0u)) ok = 0u; }
            MISC[11] = ok; }
        __syncthreads();
        uni = __builtin_amdgcn_readfirstlane((int)MISC[11]) != 0;
#ifdef MK_FORCE_NONUNI
        uni = false;
#endif
        if (uni) { const int rank = __builtin_amdgcn_readfirstlane((int)MISC[10]); C.vb = (int)bar.x * (G >> 3) + rank; cg = rank * 8 + (int)bar.x; }
    }
#endif
#ifndef MK_DN_REV
#define MK_DN_REV 0
#endif
#ifndef MK_DN_AUXA
#define MK_DN_AUXA 0
#endif
#ifndef MK_DN_AUXB
#define MK_DN_AUXB 0
#endif
#ifndef MK_UP_PFB
#define MK_UP_PFB 0
#endif
#ifndef MK_UP_AUXA
#define MK_UP_AUXA 0
#endif
#ifndef MK_UP_AUXB
#define MK_UP_AUXB 0
#endif
#ifndef PG8_ALIGN_UP
#define PG8_ALIGN_UP PG8_ALIGN
#endif
#define YEPS_FFN (f8 ? EPS * (F8_SH * F8_SW) * (F8_SH * F8_SW) : EPS)
#define SEAM_L do { if (ph >= lo && ph + 1 < hi) { if (uni) { xcd_barrier_local(bar); if (REPM & 65536) xcd_barrier_local(bar); } else xcd_barrier(bar); } ++ph; } while (0)
    for (int i = 0; i < 8; ++i) {
        const int l = i >> 1, f = i & 1; const bool f8 = ((MK_F8MASK >> i) & 1) != 0, i8 = ((MK_I8MASK >> i) & 1) != 0, i8n = ((MK_I8MASK >> (i + 1)) & 1) != 0, f8n = ((MK_F8MASK >> (i + 1)) & 1) != 0;
        if (f == 1) {
            if (RUN && (PHM & 8)) {
                pg8::Gemm g{(const bf16_t*)(ws + WS_U), (const bf16_t*)(ws + WS_WIN) + (size_t)l * NIN * 1024, M, NIN, 1024}; pg8::StaticOrder S; S.init(M, NIN, G, cg);
                pg8::EpiMixIn E{(bf16_t*)(ws + WS_Q16), (bf16_t*)(ws + WS_K16), (bf16_t*)(ws + WS_VT16), (bf16_t*)(ws + WS_PIN), (bf16_t*)(ws + WS_XM), (bf16_t*)(ws + WS_OG)};
#if MK_I8IN
                const pg8::Gemm g8{(const bf16_t*)(ws + WS_U), (const bf16_t*)(ws + WS_WIN + (size_t)l * NIN * 1024 * 2), M, NIN, 512, false, U8_BSTRIDE - (size_t)4096 * 1024};
                const pg8::EpiMixInI8 E8{E, ws + WS_U, (const float*)(ws + WS_WIN + (size_t)l * NIN * 1024 * 2 + WIN_CS)};
                for (int rep = 0; rep < NREP(8); ++rep) pg8::gemm_phase<pg8::EpiMixInI8, pg8::StaticOrder, PG8_ALIGN, PG8_SP2, 3>(C.lds, g8, S, E8, C.wv); }
#else
                for (int rep = 0; rep < NREP(8); ++rep) pg8::gemm_phase<pg8::EpiMixIn, pg8::StaticOrder, PG8_ALIGN, PG8_SP2>(C.lds, g, S, E, C.wv); }
#endif
            SEAM_L;
            if (RUN) { for (int rep = 0; rep < NREP(16); ++rep) phase_attn(C); for (int rep = 0; rep < NREP(32); ++rep) phase_pool(C, l); for (int rep = 0; rep < NREP(64); ++rep) phase_mlstm_a(C, l); }
            SEAM_L;
            if (RUN && (PHM & 128)) phase_scan(C);
            SEAM_L;
            if (RUN) { for (int rep = 0; rep < NREP(256); ++rep) phase_mlstm_c(C, l); }
            SEAM_L;
            if (RUN && (PHM & 512)) {
                pg8::Gemm g{(const bf16_t*)(ws + WS_U), (const bf16_t*)(ws + WS_WOUT) + (size_t)l * 1024 * 1024, M, 1024, 1024}; pg8::StaticOrder S; S.init(M, 1024, G, cg);
                pg8::EpiY E{(bf16_t*)(ws + WS_Y), 1024};
                for (int rep = 0; rep < NREP(512); ++rep) pg8::gemm_phase<pg8::EpiY, pg8::StaticOrder, PG8_ALIGN, PG8_SP2>(C.lds, g, S, E, C.wv); }
            SEAM_L;
            if (RUN && (PHM & 1024)) { phase_resid(C, nullptr, false, smpre, smpost, smgb, true, 1.0f, l, 1, true, l, 2, false, EPS, i8); if (REPM & 8192) phase_resid(C, nullptr, false, smpre, smpost, smgb, true, 0.0f, l, 1, true, l, 2, false, EPS, i8); if (REPM & 131072) phase_resid(C, nullptr, false, smpre, smpost, smgb, false, 0.0f, l, 1, true, l, 2, false, EPS, i8); }
            SEAM;
        }
        if (RUN && (PHM & 2048)) {
            pg8::Gemm g{(const bf16_t*)(ws + WS_U), (const bf16_t*)(ws + WS_WUP) + (size_t)(l * 2 + f) * NUP * 1024, M, NUP, 1024}; pg8::StaticOrder S; S.init(M, NUP, G, cg);
            if (i8) { const pg8::Gemm g8{(const bf16_t*)(ws + WS_U), (const bf16_t*)(ws + WS_WUP + (size_t)i * WUP_SLOT), M, NUP, 512, false, U8_BSTRIDE - (size_t)4096 * 1024};
                pg8::EpiSwigluI8 E{ws + WS_HID, f8 ? HID_PITCH8 : HID_PITCH16, f8, ws + WS_U, (const float*)(ws + WS_WUP + (size_t)i * WUP_SLOT + WUP_CS), DFF};
                for (int rep = 0; rep < NREP(2048); ++rep) pg8::gemm_phase<pg8::EpiSwigluI8, pg8::StaticOrder, PG8_ALIGN_UP, PG8_SP2, 3, MK_UP_AUXA, MK_UP_AUXB, MK_UP_PFB>(C.lds, g8, S, E, C.wv);
            } else { pg8::EpiSwigluX E{ws + WS_HID, f8 ? HID_PITCH8 : HID_PITCH16, f8};
                for (int rep = 0; rep < NREP(2048); ++rep) pg8::gemm_phase<pg8::EpiSwigluX, pg8::StaticOrder, PG8_ALIGN_UP, PG8_SP2>(C.lds, g, S, E, C.wv); } }
        SEAM_L;
        if (RUN && (PHM & 4096)) {
            pg8::Gemm g{(const bf16_t*)(ws + WS_HID), (const bf16_t*)(ws + WS_WDN) + (size_t)(l * 2 + f) * 1024 * DFF, M, 1024, f8 ? DFF / 2 : DFF, f8, 0, f8 ? HID_PITCH8 / 2 : HID_PITCH16}; pg8::StaticOrder S; S.init(M, 1024, G, cg); S.rev = MK_DN_REV;
            pg8::EpiY E{(bf16_t*)(ws + WS_Y), 1024};
            for (int rep = 0; rep < NREP(4096); ++rep) { if (f8) pg8::gemm_phase<pg8::EpiY, pg8::StaticOrder, PG8_ALIGN, PG8_SP2, 1, MK_DN_AUXA, MK_DN_AUXB>(C.lds, g, S, E, C.wv); else pg8::gemm_phase<pg8::EpiY, pg8::StaticOrder, PG8_ALIGN, PG8_SP2, 0, MK_DN_AUXA, MK_DN_AUXB>(C.lds, g, S, E, C.wv); } }
        SEAM_L;
        if (RUN && (PHM & 8192)) { const bool has_next = (i < 7); const int ln = f == 0 ? l : l + 1, sn = f == 0 ? 1 : 0;
            phase_resid(C, i == 0 ? p.in[I_X] : (const float*)nullptr, !has_next, smpre, smpost, smgb, true, 0.5f, l, f == 0 ? 0 : 2, has_next, has_next ? ln : 0, sn, f == 0, YEPS_FFN, f == 1 ? (has_next && i8n) : (MK_I8IN != 0)); if ((REPM & 8192) && has_next) phase_resid(C, nullptr, false, smpre, smpost, smgb, true, 0.0f, l, f == 0 ? 0 : 2, has_next, ln, sn, f == 0, YEPS_FFN, f == 1 ? i8n : (MK_I8IN != 0)); if ((REPM & 131072) && has_next) phase_resid(C, nullptr, false, smpre, smpost, smgb, false, 0.0f, l, f == 0 ? 0 : 2, has_next, ln, sn, f == 0, YEPS_FFN, f == 1 ? i8n : (MK_I8IN != 0)); }
        if (f == 0 || f8 != f8n) SEAM; else SEAM_L;
    }
#undef RUN
#undef SEAM
#undef SEAM_L
}

#ifndef MK_MULTI
#define MK_MULTI 0
#endif
extern "C" void kernel_launch(void* const* d_in, const int* in_sizes, int n_in, void* d_out, int out_size, void* d_ws, size_t ws_size, hipStream_t stream) {
    static int grid = 0;
    if (grid == 0) {
        if (n_in != 18 || in_sizes[0] != M * DM || out_size != M * DM || ws_size < WS_END) { fprintf(stderr, "kernel_launch: unexpected shapes (n_in %d, in0 %d, out %d, ws %zu < %zu); nothing launched\n", n_in, n_in > 0 ? in_sizes[0] : -1, out_size, ws_size, (size_t)WS_END); grid = -1; return; }
        int dev = 0, cus = 0, per_cu = 0;
        if (hipGetDevice(&dev) != hipSuccess || hipDeviceGetAttribute(&cus, hipDeviceAttributeMultiprocessorCount, dev) != hipSuccess) { grid = -1; return; }
        if (hipFuncSetAttribute((const void*)mk_fwd, hipFuncAttributeMaxDynamicSharedMemorySize, LDS_BYTES) != hipSuccess) { fprintf(stderr, "kernel_launch: hipFuncSetAttribute failed\n"); grid = -1; return; }
        if (hipOccupancyMaxActiveBlocksPerMultiprocessor(&per_cu, (const void*)mk_fwd, 512, LDS_BYTES) != hipSuccess || per_cu < 1) { fprintf(stderr, "kernel_launch: occupancy query reports %d workgroups per CU\n", per_cu); }
        (void)hipGetLastError();
        grid = cus;
    }
    if (grid < 0) return;
    if (hipMemsetAsync((char*)d_ws + WS_CTL, 0, CTL_ZERO_BYTES, stream) != hipSuccess) return;
    Params p{};
    for (int i = 0; i < 18; ++i) p.in[i] = (const float*)d_in[i];
    p.out = (float*)d_out; p.ws = (unsigned char*)d_ws;
#if MK_MULTI
#ifndef MK_MAXPH
#define MK_MAXPH N_PHASES
#endif
    for (int k = 0; k < MK_MAXPH; ++k) { p.ph_lo = k; p.ph_hi = k + 1; hipLaunchKernelGGL(mk_fwd, dim3(grid), dim3(512), LDS_BYTES, stream, p); }
#else
    p.ph_lo = 0; p.ph_hi = N_PHASES;
    hipLaunchKernelGGL(mk_fwd, dim3(grid), dim3(512), LDS_BYTES, stream, p);
#endif
}
#endif
```

```cpp
#ifndef EMU
#include <hip/hip_runtime.h>
#include <cstdio>
#include <cstdint>
#define DEV __device__ __forceinline__
#define LAS __attribute__((address_space(3)))
#define WAVE_LDS_SYNC() asm volatile("s_waitcnt lgkmcnt(0)" ::: "memory")
#define NT_LOAD(T, p) __builtin_nontemporal_load((const T*)(p))
#define NT_STORE(T, p, v) __builtin_nontemporal_store((v), (T*)(p))
#define SCHED_FENCE() __builtin_amdgcn_sched_barrier(0)
DEV unsigned f2bf(float f) { unsigned u = __builtin_bit_cast(unsigned, f); return (u + 0x7fffu + ((u >> 16) & 1u)) >> 16; }
typedef float mk_f32x2 __attribute__((ext_vector_type(2)));
typedef __bf16 mk_bf16x2 __attribute__((ext_vector_type(2)));
DEV unsigned pk2(float lo, float hi) { const mk_f32x2 v = {lo, hi}; return __builtin_bit_cast(unsigned, __builtin_convertvector(v, mk_bf16x2)); }
DEV int lnd(int x) { asm volatile("" : "+v"(x)); return x; }
DEV unsigned char* lndp(unsigned char* p) { size_t z = 0; asm volatile("" : "+s"(z)); return p + z; }
DEV int mk_lane_id() { unsigned z = 0u; asm volatile("" : "+s"(z)); return (int)__builtin_amdgcn_mbcnt_hi(~0u, __builtin_amdgcn_mbcnt_lo(~0u, z)); }
DEV bool any_lane(bool p) { return __builtin_amdgcn_ballot_w64(p) != 0ull; }
typedef unsigned mk_u32x2 __attribute__((ext_vector_type(2)));
DEV void st_wt8(void* p, mk_u32x2 v) { __hip_atomic_store((unsigned long long*)p, __builtin_bit_cast(unsigned long long, v), __ATOMIC_RELAXED, __HIP_MEMORY_SCOPE_AGENT); }
DEV void publish_rows(unsigned* cnt, int lane) { asm volatile("s_waitcnt vmcnt(0)" ::: "memory"); if (lane == 0) __hip_atomic_fetch_add(cnt, 1u, __ATOMIC_RELAXED, __HIP_MEMORY_SCOPE_AGENT); }
DEV int rfl(int x) { return __builtin_amdgcn_readfirstlane(x); }
DEV float fast_exp2(float x) { return __builtin_amdgcn_exp2f(x); }
DEV float fast_rcp(float x) { return __builtin_amdgcn_rcpf(x); }
DEV unsigned pk_fp8x4(float a, float b, float c, float d) {
    a = __builtin_amdgcn_fmed3f(a, -448.f, 448.f); b = __builtin_amdgcn_fmed3f(b, -448.f, 448.f); c = __builtin_amdgcn_fmed3f(c, -448.f, 448.f); d = __builtin_amdgcn_fmed3f(d, -448.f, 448.f);
    int w = 0; w = __builtin_amdgcn_cvt_pk_fp8_f32(a, b, w, false); w = __builtin_amdgcn_cvt_pk_fp8_f32(c, d, w, true); return (unsigned)w; }
DEV unsigned pk_i8x4(float a, float b, float c, float d) { const int ia = (int)__builtin_rintf(a), ib = (int)__builtin_rintf(b), ic = (int)__builtin_rintf(c), id = (int)__builtin_rintf(d);
    return (unsigned)(ia & 255) | ((unsigned)(ib & 255) << 8) | ((unsigned)(ic & 255) << 16) | ((unsigned)id << 24); }
DEV unsigned pk_i8x4s(float a, float b, float c, float d, float inv) { const float MG = 12582912.0f;
    const unsigned ua = __builtin_bit_cast(unsigned, __builtin_fmaf(a, inv, MG)), ub = __builtin_bit_cast(unsigned, __builtin_fmaf(b, inv, MG)), uc = __builtin_bit_cast(unsigned, __builtin_fmaf(c, inv, MG)), ud = __builtin_bit_cast(unsigned, __builtin_fmaf(d, inv, MG));
    return __builtin_amdgcn_perm(ub, ua, 0x0c0c0400u) | __builtin_amdgcn_perm(ud, uc, 0x04000c0cu); }
DEV float dot2bf(unsigned a, unsigned b, float c) { return __builtin_amdgcn_fdot2_f32_bf16(__builtin_bit_cast(mk_bf16x2, a), __builtin_bit_cast(mk_bf16x2, b), c, false); }
typedef short mk_bf16x8 __attribute__((ext_vector_type(8)));
typedef float mk_f32x4 __attribute__((ext_vector_type(4)));
DEV mk_f32x4 mfma16(mk_bf16x8 a, mk_bf16x8 b, mk_f32x4 c) { return __builtin_amdgcn_mfma_f32_16x16x32_bf16(a, b, c, 0, 0, 0); }
#endif
#ifndef MK_F8MASK
#define MK_F8MASK 0xFE
#endif
#ifndef MK_I8MASK
#define MK_I8MASK 0xFF
#endif
#ifndef MK_HIDPAD
#define MK_HIDPAD 0
#endif
#define HID_PITCH8 (2816 + MK_HIDPAD)
#define HID_PITCH16 (2816 + MK_HIDPAD / 2)
#ifndef MK_I8IN
#define MK_I8IN 0
#endif
#define F8_SH 4.0f
#define UPW_GATE (-1.4426950408889634f)
#define UPW_VAL (-0.6931471805599453f)
#define F8_SW 512.0f
#define U8_BSTRIDE ((size_t)4096 * 2048)
DEV size_t u8_row(int row) { return (size_t)(row >> 12) * U8_BSTRIDE + (size_t)(row & 4095) * 1024; }
DEV size_t u8_rs(int row) { return (size_t)(row >> 12) * U8_BSTRIDE + (size_t)4096 * 1024 + (size_t)(row & 4095) * 4; }
#ifndef MK_MULTI
#define MK_MULTI 0
#endif
#ifndef EMU
#ifndef MK_WGM
#define MK_WGM 4
#endif
namespace pg8 {
#define PG8_LAS __attribute__((address_space(3)))
typedef unsigned short bf16_t;
typedef short bf16x8 __attribute__((ext_vector_type(8)));
typedef float f32x4 __attribute__((ext_vector_type(4)));
typedef int i32x8 __attribute__((ext_vector_type(8)));
typedef int i32x4 __attribute__((ext_vector_type(4)));
typedef unsigned u32x4 __attribute__((ext_vector_type(4)));
constexpr int BM = 256, BK = 64, HALF = 128, HTB = HALF * BK * 2  , STAGE_BYTES = 8 * HTB, NXCD = 8, WGM = MK_WGM;

__host__ __device__ __forceinline__ int lds_byte(int r, int c) { const int st = (r >> 4) * 2 + (c >> 5), rr = r & 15, cc = c & 31, ob = rr * 64 + cc * 2; return st * 1024 + (ob ^ (((ob >> 9) & 1) << 5)); }
__host__ __device__ __forceinline__ void stage_rc(int b, int& R, int& C) { const int st = b / 1024, sb = b % 1024, swz = sb ^ (((sb >> 9) & 1) << 5); R = (st >> 1) * 16 + swz / 64; C = (st & 1) * 32 + (swz % 64) / 2; }
__host__ __device__ __forceinline__ int perm32(int rho) { const int n = rho >> 4, i = rho & 15; return 8 * (i >> 2) + 4 * n + (i & 3); }

struct Unit { int pm, pn; };
struct Gemm { const bf16_t* A; const bf16_t* Bt; int M, N, K; bool f8 = false; size_t a_bgap = 0; int lda = 0; };

struct StaticOrder {
    int nM, nN, nwg, G, c, rev = 0;
    __host__ __device__ void init(int M, int N, int G_, int c_) { nM = M / BM; nN = N / BM; nwg = nM * nN; G = G_; c = c_; }
    __host__ __device__ bool next(int i, Unit& u) const {
        const long L = (long)i * G + c; if (L >= nwg) return false;
        int wgid = (int)L; { const int q = nwg / NXCD, r = nwg % NXCD, xcd = wgid % NXCD, off = wgid / NXCD; wgid = (xcd < r ? xcd * (q + 1) : r * (q + 1) + (xcd - r) * q) + off; }
        const int nig = WGM * nN, gid = wgid / nig, fm = gid * WGM, gsz = (nM - fm) < WGM ? (nM - fm) : WGM;
        u.pm = fm + ((wgid % nig) % gsz); u.pn = (wgid % nig) / gsz; if (rev) u.pm ^= 15;
        return true;
    }
    __device__ __forceinline__ void a_ready(const Unit&) const {}
    __device__ __forceinline__ void done(const Unit&) const {}
};

__device__ __forceinline__ unsigned cvt_pk_bf16(float lo, float hi) { return ::pk2(lo, hi); }
typedef float f32x2 __attribute__((ext_vector_type(2)));
typedef unsigned u32x2 __attribute__((ext_vector_type(2)));
__device__ __forceinline__ float silu_f(float g) { return g * __builtin_amdgcn_rcpf(1.0f + __expf(-g)); }
struct EpiSwiglu {
    static constexpr bool PERM = true, AFTER_DRAIN = false;
    bf16_t* H; int ldh;
    __device__ __forceinline__ void operator()(const f32x4 (&acc)[2][2][4][2], const Unit& u, int wr, int wc, int fr, int fq) const {
        const int row0 = u.pm * BM + wr * 64 + fr, col0 = u.pn * HALF + wc * 32 + 8 * fq;
#pragma unroll
        for (int ai = 0; ai < 2; ++ai)
#pragma unroll
            for (int m = 0; m < 4; ++m) { bf16_t* rowp = H + (size_t)(row0 + ai * HALF + m * 16) * ldh + col0;
                const f32x4 g0 = acc[ai][0][m][0], g1 = acc[ai][0][m][1], v0 = acc[ai][1][m][0], v1 = acc[ai][1][m][1];
                u32x4 w; w.x = cvt_pk_bf16(silu_f(g0[0]) * v0[0], silu_f(g0[1]) * v0[1]); w.y = cvt_pk_bf16(silu_f(g0[2]) * v0[2], silu_f(g0[3]) * v0[3]);
                w.z = cvt_pk_bf16(silu_f(g1[0]) * v1[0], silu_f(g1[1]) * v1[1]); w.w = cvt_pk_bf16(silu_f(g1[2]) * v1[2], silu_f(g1[3]) * v1[3]);
                *(u32x4*)rowp = w; }
    }
};
__device__ __forceinline__ f32x2 swiglu2(float ga, float gb, float va, float vb) {
    const f32x2 g = {ga, gb}, v = {va, vb}; f32x2 d = {__builtin_amdgcn_exp2f(ga), __builtin_amdgcn_exp2f(gb)}; d = d + 1.0f;
    const f32x2 r = {__builtin_amdgcn_rcpf(d[0]), __builtin_amdgcn_rcpf(d[1])}; return (g * v) * r; }
struct EpiSwigluX {
    static constexpr bool PERM = true, AFTER_DRAIN = false;
    unsigned char* H; int ldh; bool f8;
    __device__ __forceinline__ void operator()(const f32x4 (&acc)[2][2][4][2], const Unit& u, int wr, int wc, int fr, int fq) const {
        const int row0 = u.pm * BM + wr * 64 + fr, col0 = u.pn * HALF + wc * 32 + 8 * fq;
        if (f8) {
#pragma unroll
            for (int ai = 0; ai < 2; ++ai)
#pragma unroll
                for (int m = 0; m < 4; ++m) { unsigned char* rowp = H + (size_t)(row0 + ai * HALF + m * 16) * ldh + col0;
                    const f32x4 g0 = acc[ai][0][m][0], g1 = acc[ai][0][m][1], v0 = acc[ai][1][m][0], v1 = acc[ai][1][m][1];
                    const f32x2 a = swiglu2(g0[0], g0[1], v0[0], v0[1]), b = swiglu2(g0[2], g0[3], v0[2], v0[3]), c = swiglu2(g1[0], g1[1], v1[0], v1[1]), d = swiglu2(g1[2], g1[3], v1[2], v1[3]);
                    u32x2 w; w.x = ::pk_fp8x4(a[0], a[1], b[0], b[1]); w.y = ::pk_fp8x4(c[0], c[1], d[0], d[1]);
                    *(u32x2*)rowp = w; }
        } else {
#pragma unroll
            for (int ai = 0; ai < 2; ++ai)
#pragma unroll
                for (int m = 0; m < 4; ++m) { bf16_t* rowp = (bf16_t*)H + (size_t)(row0 + ai * HALF + m * 16) * ldh + col0;
                    const f32x4 g0 = acc[ai][0][m][0], g1 = acc[ai][0][m][1], v0 = acc[ai][1][m][0], v1 = acc[ai][1][m][1];
                    const f32x2 a = swiglu2(g0[0], g0[1], v0[0], v0[1]), b = swiglu2(g0[2], g0[3], v0[2], v0[3]), c = swiglu2(g1[0], g1[1], v1[0], v1[1]), d = swiglu2(g1[2], g1[3], v1[2], v1[3]);
                    u32x4 w; w.x = cvt_pk_bf16(a[0], a[1]); w.y = cvt_pk_bf16(b[0], b[1]); w.z = cvt_pk_bf16(c[0], c[1]); w.w = cvt_pk_bf16(d[0], d[1]);
                    *(u32x4*)rowp = w; }
        }
    }
};
#ifndef MK_HID_NT
#define MK_HID_NT 0
#endif
#if MK_HID_NT
#define HID_STORE(T, p, v) __builtin_nontemporal_store((v), (T*)(p))
#else
#define HID_STORE(T, p, v) (*(T*)(p) = (v))
#endif
template <bool F8C> struct EpiSwigluI8T {
    static constexpr bool PERM = true, AFTER_DRAIN = false;
    unsigned char* H; int ldh; bool f8_unused; const unsigned char* U8; const float* CS; int dff;
    __device__ __forceinline__ void operator()(const f32x4 (&acc)[2][2][4][2], const Unit& u, int wr, int wc, int fr, int fq) const {
        const int row0 = u.pm * BM + wr * 64 + fr, col0 = u.pn * HALF + wc * 32 + 8 * fq;
        const f32x4 cg0 = *(const f32x4*)(CS + col0), cg1 = *(const f32x4*)(CS + col0 + 4), cv0 = *(const f32x4*)(CS + dff + col0), cv1 = *(const f32x4*)(CS + dff + col0 + 4);
        float rsv[2][4];
#pragma unroll
        for (int ai = 0; ai < 2; ++ai)
#pragma unroll
            for (int m = 0; m < 4; ++m) rsv[ai][m] = *(const float*)(U8 + ::u8_rs(row0 + ai * HALF + m * 16));
#ifdef EPIREP
        for (int rep_ = 0; rep_ < EPIREP; ++rep_) { asm volatile("" ::: "memory");
#endif
#pragma unroll
        for (int ai = 0; ai < 2; ++ai)
#pragma unroll
            for (int m = 0; m < 4; ++m) { const size_t ro = (size_t)(row0 + ai * HALF + m * 16) * ldh + col0; const float rs = rsv[ai][m];
                const f32x4 g0 = __builtin_convertvector(__builtin_bit_cast(i32x4, acc[ai][0][m][0]), f32x4) * (cg0 * rs), g1 = __builtin_convertvector(__builtin_bit_cast(i32x4, acc[ai][0][m][1]), f32x4) * (cg1 * rs);
                const f32x4 v0 = __builtin_convertvector(__builtin_bit_cast(i32x4, acc[ai][1][m][0]), f32x4) * (cv0 * rs), v1 = __builtin_convertvector(__builtin_bit_cast(i32x4, acc[ai][1][m][1]), f32x4) * (cv1 * rs);
                const f32x2 a = swiglu2(g0[0], g0[1], v0[0], v0[1]), b = swiglu2(g0[2], g0[3], v0[2], v0[3]), c = swiglu2(g1[0], g1[1], v1[0], v1[1]), d = swiglu2(g1[2], g1[3], v1[2], v1[3]);
                if (F8C) { u32x2 w; w.x = ::pk_fp8x4(a[0], a[1], b[0], b[1]); w.y = ::pk_fp8x4(c[0], c[1], d[0], d[1]); HID_STORE(u32x2, H + ro, w); }
                else { u32x4 w; w.x = cvt_pk_bf16(a[0], a[1]); w.y = cvt_pk_bf16(b[0], b[1]); w.z = cvt_pk_bf16(c[0], c[1]); w.w = cvt_pk_bf16(d[0], d[1]); HID_STORE(u32x4, (bf16_t*)H + ro, w); } }
#ifdef EPIREP
        }
#endif
    }
};
struct EpiY {
    static constexpr bool PERM = true, AFTER_DRAIN = false;
    bf16_t* O; int ldc;
    __device__ __forceinline__ void operator()(const f32x4 (&acc)[2][2][4][2], const Unit& u, int wr, int wc, int fr, int fq) const {
        const int row0 = u.pm * BM + wr * 64 + fr, col0 = u.pn * BM + wc * 32 + 8 * fq;
#pragma unroll
        for (int ai = 0; ai < 2; ++ai)
#pragma unroll
            for (int m = 0; m < 4; ++m) { bf16_t* rowp = O + (size_t)(row0 + ai * HALF + m * 16) * ldc + col0;
#pragma unroll
                for (int bj = 0; bj < 2; ++bj) { const f32x4 v0 = acc[ai][bj][m][0], v1 = acc[ai][bj][m][1];
                    u32x4 w; w.x = cvt_pk_bf16(v0[0], v0[1]); w.y = cvt_pk_bf16(v0[2], v0[3]); w.z = cvt_pk_bf16(v1[0], v1[1]); w.w = cvt_pk_bf16(v1[2], v1[3]);
                    *(u32x4*)(rowp + bj * HALF) = w; } }
    }
};
struct EpiMixIn {
    static constexpr bool PERM = false, AFTER_DRAIN = false;
    bf16_t *Q16, *K16, *VT16, *PIN, *XM, *OG;
    __device__ __forceinline__ void operator()(const f32x4 (&acc)[2][2][4][2], const Unit& u, int wr, int wc, int fr, int fq) const {
        const int pn = u.pn, rowb = u.pm * BM + wr * 64 + fr, tc0 = wc * 32 + 4 * fq;
        if (pn <= 1) {
            bf16_t* base = pn == 0 ? Q16 : K16; const float sc = pn == 0 ? 0.18033688011112042f : 1.0f;
#pragma unroll
            for (int ai = 0; ai < 2; ++ai)
#pragma unroll
                for (int m = 0; m < 4; ++m) { const int row = rowb + ai * HALF + m * 16, b = row >> 12, s = row & 4095, r = s & 15, j = s >> 4;
#pragma unroll
                    for (int bj = 0; bj < 2; ++bj)
#pragma unroll
                        for (int n = 0; n < 2; ++n) { const int tc = bj * HALF + n * 16 + tc0, hd = tc >> 6, d = tc & 63; const f32x4 v = acc[ai][bj][m][n] * sc;
                            u32x2 w; w.x = cvt_pk_bf16(v[0], v[1]); w.y = cvt_pk_bf16(v[2], v[3]);
                            *(u32x2*)(base + (((((size_t)(b * 4 + hd) * 16 + r) * 16 + (j >> 4)) * 1024) + (d >> 5) * 512 + (j & 15) * 32 + ((d >> 3) & 3) * 8 + (d & 7))) = w; } }
        } else if (pn == 2) {
            const int b = (u.pm * BM) >> 12, jb = ((u.pm * BM) & 4095) >> 4;
#pragma unroll
            for (int ai = 0; ai < 2; ++ai)
#pragma unroll
                for (int bj = 0; bj < 2; ++bj)
#pragma unroll
                    for (int n = 0; n < 2; ++n) { const int tc = bj * HALF + n * 16 + tc0, hd = tc >> 6, d = tc & 63;
#pragma unroll
                        for (int e = 0; e < 4; ++e) { u32x2 w; w.x = cvt_pk_bf16(acc[ai][bj][0][n][e], acc[ai][bj][1][n][e]); w.y = cvt_pk_bf16(acc[ai][bj][2][n][e], acc[ai][bj][3][n][e]);
                            *(u32x2*)(VT16 + (((((size_t)(b * 4 + hd) * 16 + fr) * 16 + (jb >> 4)) * 1024) + (d + e) * 16 + 8 * ai + 4 * wr)) = w; } }
        } else {
            bf16_t* base; int ld, c0;
            if (pn == 3) { base = PIN; ld = 256; c0 = 0; } else if (pn <= 5) { base = XM; ld = 512; c0 = (pn - 4) * 256; } else { base = OG; ld = 512; c0 = (pn - 6) * 256; }
#pragma unroll
            for (int ai = 0; ai < 2; ++ai)
#pragma unroll
                for (int m = 0; m < 4; ++m) { bf16_t* rowp = base + (size_t)(rowb + ai * HALF + m * 16) * ld + c0 + tc0;
#pragma unroll
                    for (int bj = 0; bj < 2; ++bj)
#pragma unroll
                        for (int n = 0; n < 2; ++n) { const f32x4 v = acc[ai][bj][m][n]; u32x2 w; w.x = cvt_pk_bf16(v[0], v[1]); w.y = cvt_pk_bf16(v[2], v[3]);
                            *(u32x2*)(rowp + bj * HALF + n * 16) = w; } }
        }
    }
};
struct EpiMixInI8 {
    static constexpr bool PERM = false, AFTER_DRAIN = false;
    EpiMixIn base; const unsigned char* U8; const float* CS;
    __device__ __forceinline__ void operator()(const f32x4 (&acc_)[2][2][4][2], const Unit& u, int wr, int wc, int fr, int fq) const {
        f32x4 (&acc)[2][2][4][2] = const_cast<f32x4 (&)[2][2][4][2]>(acc_);
        const int rowb = u.pm * BM + wr * 64 + fr, tc0 = u.pn * BM + wc * 32 + 4 * fq;
        f32x4 cs[2][2]; float rsv[2][4];
#pragma unroll
        for (int bj = 0; bj < 2; ++bj)
#pragma unroll
            for (int n = 0; n < 2; ++n) cs[bj][n] = *(const f32x4*)(CS + tc0 + bj * HALF + n * 16);
#pragma unroll
        for (int ai = 0; ai < 2; ++ai)
#pragma unroll
            for (int m = 0; m < 4; ++m) rsv[ai][m] = *(const float*)(U8 + ::u8_rs(rowb + ai * HALF + m * 16));
#pragma unroll
        for (int ai = 0; ai < 2; ++ai)
#pragma unroll
            for (int m = 0; m < 4; ++m)
#pragma unroll
                for (int bj = 0; bj < 2; ++bj)
#pragma unroll
                    for (int n = 0; n < 2; ++n) acc[ai][bj][m][n] = __builtin_convertvector(__builtin_bit_cast(i32x4, acc[ai][bj][m][n]), f32x4) * (cs[bj][n] * rsv[ai][m]);
        base(acc, u, wr, wc, fr, fq);
    }
};
#ifndef MK_STG_IN_MMA
#define MK_STG_IN_MMA 0
#endif
template <class Epi, class Sched, bool ALIGN_EPI = false, bool SP2 = false, int F8 = 0, int AUXA = 0, int AUXB = 0, int PFB = 0>
__device__ __forceinline__ void gemm_phase(PG8_LAS unsigned char* lds, const Gemm g, const Sched& S, const Epi& E, const int wave_sgpr) {
    int lane_ = ::mk_lane_id(); asm volatile("" : "+v"(lane_)); const int wid = wave_sgpr, tid = wid * 64 + lane_, lane = tid & 63, wr = wid >> 2, wc = wid & 3, fr = lane & 15, fq = lane >> 4;
    const int K = g.K, nt = K / BK, LDA = g.lda ? g.lda : K; const bool f8 = F8 == 2 ? g.f8 : (F8 == 1);
    unsigned voffA, voffB;
    { int R, C; stage_rc(tid * 16, R, C); const int Rb = Epi::PERM ? ((R & ~31) + perm32(R & 31)) : R;
        voffA = (unsigned)(R * LDA + C) * 2u; voffB = (unsigned)(Rb * K + C) * 2u; }
    const size_t qstep = (size_t)64 * K * 2, qstepA = (size_t)64 * LDA * 2;
    const size_t kstep = (size_t)(BK * 2);
    const size_t hstep = (size_t)HALF * K * 2, hstepA = (size_t)HALF * LDA * 2;
    const size_t tstep = 2 * hstep, tstepA = 2 * hstepA;
    const unsigned ldsw = (unsigned)wid * 1024u;
    const int aoff = lds_byte(wr * 64 + fr, fq * 8), boff = lds_byte(wc * 32 + fr, fq * 8);
#define PG8_SA(b, h) (((b) * 2 + (h)) * HTB)
#define PG8_SB(b, h) ((4 + (b) * 2 + (h)) * HTB)
#define PG8_STAGE_Q(bufoff, gbase, voff, qs, aux) do { const char* gb_ = (const char*)(gbase); asm volatile("" : "+s"(gb_)); const char* gb2_ = gb_ + (qs); asm volatile("" : "+s"(gb2_));        \
        unsigned vo_ = (voff); asm volatile("" : "+v"(vo_));        \
        __builtin_amdgcn_global_load_lds((const unsigned*)(gb_ + vo_), (PG8_LAS unsigned*)(lds + (bufoff) + ldsw), 16, 0, aux); \
        __builtin_amdgcn_global_load_lds((const unsigned*)(gb2_ + vo_), (PG8_LAS unsigned*)(lds + (bufoff) + ldsw + 8192), 16, 0, aux); } while (0)
#define PG8_STAGE(bufoff, gbase, voff) PG8_STAGE_Q(bufoff, gbase, voff, qstep, AUXB)
#define PG8_STAGEA(bufoff, gbase, voff) PG8_STAGE_Q(bufoff, gbase, voff, qstepA, AUXA)
#define PG8_LDA(dst, b, h) do { _Pragma("unroll") for (int m = 0; m < 4; ++m) _Pragma("unroll") for (int k = 0; k < 2; ++k) dst[m][k] = *(const PG8_LAS bf16x8*)(lds + PG8_SA(b, h) + aoff + m * 2048 + k * 1024); } while (0)
#define PG8_LDB(dst, b, h) do { _Pragma("unroll") for (int n = 0; n < 2; ++n) _Pragma("unroll") for (int k = 0; k < 2; ++k) dst[n][k] = *(const PG8_LAS bf16x8*)(lds + PG8_SB(b, h) + boff + n * 2048 + k * 1024); } while (0)
#define PG8_CAT(x) __builtin_bit_cast(i32x8, __builtin_shufflevector((x)[0], (x)[1], 0, 1, 2, 3, 4, 5, 6, 7, 8, 9, 10, 11, 12, 13, 14, 15))
#define PG8_MMA_R(ai, bj, At, Bt, m0, m1) do { __builtin_amdgcn_s_setprio(1); if constexpr (F8 == 3) { _Pragma("unroll") for (int m = (m0); m < (m1); ++m) _Pragma("unroll") for (int n = 0; n < 2; ++n) _Pragma("unroll") for (int k = 0; k < 2; ++k) \
        acc[ai][bj][m][n] = __builtin_bit_cast(f32x4, __builtin_amdgcn_mfma_i32_16x16x64_i8(__builtin_bit_cast(i32x4, Bt[n][k]), __builtin_bit_cast(i32x4, At[m][k]), __builtin_bit_cast(i32x4, acc[ai][bj][m][n]), 0, 0, 0)); } else if (f8) { _Pragma("unroll") for (int m = (m0); m < (m1); ++m) _Pragma("unroll") for (int n = 0; n < 2; ++n) \
        acc[ai][bj][m][n] = __builtin_amdgcn_mfma_scale_f32_16x16x128_f8f6f4(PG8_CAT(Bt[n]), PG8_CAT(At[m]), acc[ai][bj][m][n], 0, 0, 0, 0, 0, 0); } else { \
        _Pragma("unroll") for (int m = (m0); m < (m1); ++m) _Pragma("unroll") for (int n = 0; n < 2; ++n) _Pragma("unroll") for (int k = 0; k < 2; ++k) \
        acc[ai][bj][m][n] = __builtin_amdgcn_mfma_f32_16x16x32_bf16(Bt[n][k], At[m][k], acc[ai][bj][m][n], 0, 0, 0); } __builtin_amdgcn_s_setprio(0); } while (0)
#define PG8_MMA(ai, bj, At, Bt) PG8_MMA_R(ai, bj, At, Bt, 0, 4)
#define PG8_WAIT_V(n) asm volatile("s_waitcnt vmcnt(" #n ")" ::: "memory")
#define PG8_WAIT_L(n) asm volatile("s_waitcnt lgkmcnt(" #n ")" ::: "memory")
#define PG8_BAR __builtin_amdgcn_s_barrier()
#define PG8_SCHED __builtin_amdgcn_sched_barrier(0)
    Unit cur, nxt; int ui = 0;
    if (!S.next(0, cur)) return;
    f32x4 acc[2][2][4][2];
#pragma unroll
    for (int a = 0; a < 2; ++a)
#pragma unroll
        for (int b = 0; b < 2; ++b)
#pragma unroll
            for (int m = 0; m < 4; ++m)
#pragma unroll
                for (int n = 0; n < 2; ++n) acc[a][b][m][n] = (f32x4){0.f, 0.f, 0.f, 0.f};
    bf16x8 At[4][2], B0[2][2], B1[2][2];
    const char* cA = (const char*)g.A + (size_t)cur.pm * tstepA + (size_t)(cur.pm >> 4) * g.a_bgap; const char* cB = (const char*)g.Bt + (size_t)cur.pn * tstep;
    S.a_ready(cur);
    if constexpr (SP2) {
        PG8_STAGE(PG8_SB(0, 0), cB, voffB); PG8_STAGE(PG8_SB(0, 1), cB + hstep, voffB); PG8_STAGEA(PG8_SA(0, 0), cA, voffA); PG8_STAGEA(PG8_SA(0, 1), cA + hstepA, voffA);
        if (wr == 1) PG8_BAR;
        PG8_WAIT_V(2); PG8_BAR;
        PG8_STAGE(PG8_SB(1, 0), cB + kstep, voffB); PG8_STAGEA(PG8_SA(1, 0), cA + kstep, voffA); PG8_STAGE(PG8_SB(1, 1), cB + hstep + kstep, voffB);
        PG8_WAIT_V(6); PG8_BAR;
    } else {
        PG8_STAGE(PG8_SB(0, 0), cB, voffB); PG8_STAGEA(PG8_SA(0, 0), cA, voffA); PG8_STAGE(PG8_SB(0, 1), cB + hstep, voffB); PG8_STAGEA(PG8_SA(0, 1), cA + hstepA, voffA);
        if (wr == 1) PG8_BAR;
        PG8_WAIT_V(4); PG8_BAR;
        PG8_STAGE(PG8_SB(1, 0), cB + kstep, voffB); PG8_STAGEA(PG8_SA(1, 0), cA + kstep, voffA); PG8_STAGE(PG8_SB(1, 1), cB + hstep + kstep, voffB);
        PG8_WAIT_V(6); PG8_BAR;
    }
    for (;;) {
        const bool has_next = S.next(ui + 1, nxt);
        const char* nA = has_next ? (const char*)g.A + (size_t)nxt.pm * tstepA + (size_t)(nxt.pm >> 4) * g.a_bgap : cA; const char* nB = has_next ? (const char*)g.Bt + (size_t)nxt.pn * tstep : cB;
        for (int t = 0; t < nt; t += 2) {
            const bool last = (t == nt - 2);
            const char* a1 = cA + (size_t)(t + 1) * kstep;
            const char* a2 = last ? nA : cA + (size_t)(t + 2) * kstep; const char* b2 = last ? nB : cB + (size_t)(t + 2) * kstep;
            const char* a3 = a2 + kstep; const char* b3 = b2 + kstep;
            if (last && has_next) S.a_ready(nxt);
            if constexpr (SP2) {
#if MK_STG_IN_MMA
            PG8_LDB(B0, 0, 0); PG8_LDB(B1, 0, 1); PG8_SCHED; PG8_LDA(At, 0, 0);
            PG8_WAIT_V(6); PG8_WAIT_L(0); PG8_BAR; PG8_MMA_R(0, 0, At, B0, 0, 1); PG8_STAGEA(PG8_SA(1, 1), a1 + hstepA, voffA); PG8_MMA_R(0, 0, At, B0, 1, 4); PG8_MMA(0, 1, At, B1); PG8_BAR; PG8_SCHED;
            PG8_LDA(At, 0, 1);
            PG8_WAIT_V(2); PG8_WAIT_L(0); PG8_BAR; PG8_MMA_R(1, 0, At, B0, 0, 1); PG8_STAGE(PG8_SB(0, 0), b2, voffB); PG8_MMA_R(1, 0, At, B0, 1, 2); PG8_STAGE(PG8_SB(0, 1), b2 + hstep, voffB); PG8_MMA_R(1, 0, At, B0, 2, 3); PG8_STAGEA(PG8_SA(0, 0), a2, voffA); PG8_MMA_R(1, 0, At, B0, 3, 4); PG8_MMA(1, 1, At, B1); PG8_BAR; PG8_SCHED;
            PG8_LDB(B0, 1, 0); PG8_LDB(B1, 1, 1); PG8_SCHED; PG8_LDA(At, 1, 0);
            PG8_WAIT_V(6); PG8_WAIT_L(0); PG8_BAR; PG8_MMA_R(0, 0, At, B0, 0, 1); PG8_STAGEA(PG8_SA(0, 1), a2 + hstepA, voffA); PG8_MMA_R(0, 0, At, B0, 1, 4); PG8_MMA(0, 1, At, B1); PG8_BAR; PG8_SCHED;
            PG8_LDA(At, 1, 1);
            PG8_WAIT_V(2); PG8_WAIT_L(0); PG8_BAR; PG8_MMA_R(1, 0, At, B0, 0, 1); PG8_STAGE(PG8_SB(1, 0), b3, voffB); PG8_MMA_R(1, 0, At, B0, 1, 2); PG8_STAGE(PG8_SB(1, 1), b3 + hstep, voffB); PG8_MMA_R(1, 0, At, B0, 2, 3); PG8_STAGEA(PG8_SA(1, 0), a3, voffA); PG8_MMA_R(1, 0, At, B0, 3, 4); PG8_MMA(1, 1, At, B1); PG8_BAR; PG8_SCHED;
#else
            PG8_LDB(B0, 0, 0); PG8_LDB(B1, 0, 1); PG8_SCHED; PG8_LDA(At, 0, 0); PG8_STAGEA(PG8_SA(1, 1), a1 + hstepA, voffA);
            PG8_WAIT_V(8); PG8_WAIT_L(0); PG8_BAR; PG8_MMA(0, 0, At, B0); PG8_MMA(0, 1, At, B1); PG8_BAR; PG8_SCHED;
            PG8_LDA(At, 0, 1); PG8_STAGE(PG8_SB(0, 0), b2, voffB); PG8_STAGE(PG8_SB(0, 1), b2 + hstep, voffB); PG8_STAGEA(PG8_SA(0, 0), a2, voffA);
            PG8_WAIT_V(8); PG8_WAIT_L(0); PG8_BAR; PG8_MMA(1, 0, At, B0); PG8_MMA(1, 1, At, B1); PG8_BAR; PG8_SCHED;
            PG8_LDB(B0, 1, 0); PG8_LDB(B1, 1, 1); PG8_SCHED; PG8_LDA(At, 1, 0); PG8_STAGEA(PG8_SA(0, 1), a2 + hstepA, voffA);
            PG8_WAIT_V(8); PG8_WAIT_L(0); PG8_BAR; PG8_MMA(0, 0, At, B0); PG8_MMA(0, 1, At, B1); PG8_BAR; PG8_SCHED;
            PG8_LDA(At, 1, 1); PG8_STAGE(PG8_SB(1, 0), b3, voffB); PG8_STAGE(PG8_SB(1, 1), b3 + hstep, voffB); PG8_STAGEA(PG8_SA(1, 0), a3, voffA);
            PG8_WAIT_V(8); PG8_WAIT_L(0); PG8_BAR; PG8_MMA(1, 0, At, B0); PG8_MMA(1, 1, At, B1); PG8_BAR; PG8_SCHED;
#endif
            } else {
            PG8_LDB(B0, 0, 0); PG8_SCHED; PG8_LDA(At, 0, 0); PG8_STAGEA(PG8_SA(1, 1), a1 + hstepA, voffA);
            PG8_WAIT_L(8); PG8_BAR; PG8_WAIT_L(0); PG8_MMA(0, 0, At, B0); PG8_BAR; PG8_SCHED;
            PG8_LDB(B1, 0, 1); PG8_STAGE(PG8_SB(0, 0), b2, voffB);
            PG8_BAR; PG8_WAIT_L(0); PG8_MMA(0, 1, At, B1); PG8_BAR;
            PG8_LDA(At, 0, 1); PG8_STAGEA(PG8_SA(0, 0), a2, voffA);
            PG8_BAR; PG8_WAIT_L(0); PG8_MMA(1, 0, At, B0); PG8_BAR; PG8_SCHED;
            PG8_STAGE(PG8_SB(0, 1), b2 + hstep, voffB);
            PG8_WAIT_V(6); PG8_BAR; PG8_MMA(1, 1, At, B1); PG8_BAR;
            PG8_LDB(B0, 1, 0); PG8_SCHED; PG8_LDA(At, 1, 0); PG8_STAGEA(PG8_SA(0, 1), a2 + hstepA, voffA);
            PG8_WAIT_L(8); PG8_BAR; PG8_WAIT_L(0); PG8_MMA(0, 0, At, B0); PG8_BAR; PG8_SCHED;
            PG8_LDB(B1, 1, 1); PG8_STAGE(PG8_SB(1, 0), b3, voffB);
            PG8_BAR; PG8_WAIT_L(0); PG8_MMA(0, 1, At, B1); PG8_BAR;
            PG8_LDA(At, 1, 1); PG8_STAGEA(PG8_SA(1, 0), a3, voffA);
            PG8_BAR; PG8_WAIT_L(0); PG8_MMA(1, 0, At, B0); PG8_BAR; PG8_SCHED;
            PG8_STAGE(PG8_SB(1, 1), b3 + hstep, voffB);
            PG8_WAIT_V(6); PG8_BAR; PG8_MMA(1, 1, At, B1); PG8_BAR;
            }
        }
        if constexpr (ALIGN_EPI) { if (wr == 0) PG8_BAR; }
        if constexpr (!Epi::AFTER_DRAIN) { E(acc, cur, wr, wc, fr, fq); S.done(cur); }
        if (!has_next) break;
#pragma unroll
        for (int a = 0; a < 2; ++a)
#pragma unroll
            for (int b = 0; b < 2; ++b)
#pragma unroll
                for (int m = 0; m < 4; ++m)
#pragma unroll
                    for (int n = 0; n < 2; ++n) acc[a][b][m][n] = (f32x4){0.f, 0.f, 0.f, 0.f};
        cur = nxt; cA = nA; cB = nB; ++ui;
        if constexpr (ALIGN_EPI) { if (wr == 1) PG8_BAR; }
    }
    PG8_WAIT_V(0);
    if constexpr (!ALIGN_EPI) { if (wr == 0) PG8_BAR; }
    PG8_BAR;
    if constexpr (Epi::AFTER_DRAIN) { E.fused(acc, cur, wr, wc, fr, fq, lds, wid, lane); S.done(cur); }
#undef PG8_SA
#undef PG8_SB
#undef PG8_STAGE
#undef PG8_STAGEA
#undef PG8_STAGE_Q
#undef PG8_LDA
#undef PG8_LDB
#undef PG8_MMA
#undef PG8_MMA_R
#undef PG8_CAT
#undef PG8_WAIT_V
#undef PG8_WAIT_L
#undef PG8_BAR
#undef PG8_SCHED
}
}
#ifndef PG8_DUMMY_END
#endif
#define XB_TMO      128
#define XB_XCNT(j)  (256  + 64 * (j))
#define XB_XSUB(j)  (1280 + 64 * (j))
#define XB_XGEN(j)  (2304 + 64 * (j))
#define XB_TOP      3328
#define XB_TOPGEN   3392
#define XCD_BAR_WORDS 3456
#define XB_SPIN_CAP (1u << 18)

__device__ __forceinline__ unsigned xb_ld(unsigned* p)              { return __hip_atomic_load(p, __ATOMIC_RELAXED, __HIP_MEMORY_SCOPE_AGENT); }
__device__ __forceinline__ unsigned xb_add(unsigned* p, unsigned v) { return __hip_atomic_fetch_add(p, v, __ATOMIC_RELAXED, __HIP_MEMORY_SCOPE_AGENT); }
__device__ __forceinline__ unsigned xb_xcc_id() { return (unsigned)__builtin_amdgcn_s_getreg((3 << 11) | 20) & 0xFu; }
#define XB_SPIN(cond, bar) do { unsigned _sp = 0; while (cond) { __builtin_amdgcn_s_sleep(1); \
    if ((++_sp & 255u) == 0u) { if (xb_ld(&(bar)[XB_TMO])) break; if (_sp > XB_SPIN_CAP) { atomicAdd(&(bar)[XB_TMO], 1u); break; } } } } while (0)

struct XcdBarrier {
    int wv;
    unsigned* bar; unsigned x;
    volatile LAS unsigned* st;
};

__device__ __forceinline__ XcdBarrier xcd_barrier_post(unsigned* bar, volatile LAS unsigned* st, int wv) {
    XcdBarrier b; b.wv = wv; b.bar = bar; b.x = xb_xcc_id(); b.st = st;
    if (wv == 0 && mk_lane_id() == 0) (void)xb_add(&bar[XB_XCNT(b.x)], 1u);
    return b;
}
__device__ __forceinline__ void xcd_barrier_complete(unsigned* bar, unsigned x, unsigned& nloc, unsigned& nx) {
    const unsigned G = gridDim.x * gridDim.y * gridDim.z;
    unsigned sum, cnt, mine, sp = 0u;
    for (;;) {
        sum = 0u; cnt = 0u; mine = 0u;
#pragma unroll
        for (unsigned j = 0; j < 16; ++j) { const unsigned c = xb_ld(&bar[XB_XCNT(j)]); sum += c; cnt += (c > 0u) ? 1u : 0u; mine = (j == x) ? c : mine; }
        if (sum == G) break;
        __builtin_amdgcn_s_sleep(1);
        if ((++sp & 255u) == 0u) { if (xb_ld(&bar[XB_TMO])) break; if (sp > XB_SPIN_CAP) { atomicAdd(&bar[XB_TMO], 1u); break; } }
    }
    nloc = mine > 0u ? mine : 1u; nx = cnt > 0u ? cnt : 1u;
}

__device__ __forceinline__ void xcd_barrier(const XcdBarrier& b) {
    asm volatile("s_waitcnt vmcnt(0)" ::: "memory");
    __syncthreads();
    if (b.wv == 0 && mk_lane_id() == 0) {
        unsigned* bar = b.bar;
        __builtin_amdgcn_s_waitcnt(0);
        unsigned nloc = b.st[0], nx = b.st[1];
        if (nloc == 0u) { xcd_barrier_complete(bar, b.x, nloc, nx); b.st[0] = nloc; b.st[1] = nx; }
        const unsigned old = xb_add(&bar[XB_XSUB(b.x)], 1u);
        const unsigned gen = old / nloc;
        if (old + 1u == (gen + 1u) * nloc) {
            __builtin_amdgcn_fence(__ATOMIC_RELEASE, "agent");
            asm volatile("s_waitcnt vmcnt(0)" ::: "memory");
            const unsigned og = xb_add(&bar[XB_TOP], 1u);
            const unsigned tg = og / nx;
            if (og + 1u == (tg + 1u) * nx) xb_add(&bar[XB_TOPGEN], 1u);
            else XB_SPIN(xb_ld(&bar[XB_TOPGEN]) == tg, bar);
            __builtin_amdgcn_fence(__ATOMIC_ACQUIRE, "agent");
            xb_add(&bar[XB_XGEN(b.x)], 1u);
            asm volatile("s_waitcnt vmcnt(0)" ::: "memory");
        } else {
            XB_SPIN(xb_ld(&bar[XB_XGEN(b.x)]) == gen, bar);
            __builtin_amdgcn_fence(__ATOMIC_ACQUIRE, "agent");
            asm volatile("s_waitcnt vmcnt(0)" ::: "memory");
        }
    }
    __syncthreads();
}

#ifndef MK_LOCAL_NOWB
#define MK_LOCAL_NOWB 1
#endif
__device__ __forceinline__ void xcd_barrier_local(const XcdBarrier& b) {
    asm volatile("s_waitcnt vmcnt(0)" ::: "memory");
    __syncthreads();
    if (b.wv == 0 && mk_lane_id() == 0) {
        unsigned* bar = b.bar;
        __builtin_amdgcn_s_waitcnt(0);
        unsigned nloc = b.st[0], nx = b.st[1];
        if (nloc == 0u) { xcd_barrier_complete(bar, b.x, nloc, nx); b.st[0] = nloc; b.st[1] = nx; }
        const unsigned old = xb_add(&bar[XB_XSUB(b.x)], 1u);
        const unsigned gen = old / nloc;
        if (old + 1u == (gen + 1u) * nloc) {
#if !MK_LOCAL_NOWB
            __builtin_amdgcn_fence(__ATOMIC_RELEASE, "agent");
            asm volatile("s_waitcnt vmcnt(0)" ::: "memory");
#endif
            __builtin_amdgcn_fence(__ATOMIC_ACQUIRE, "agent");
            xb_add(&bar[XB_XGEN(b.x)], 1u);
            asm volatile("s_waitcnt vmcnt(0)" ::: "memory");
        } else {
            XB_SPIN(xb_ld(&bar[XB_XGEN(b.x)]) == gen, bar);
            __builtin_amdgcn_fence(__ATOMIC_ACQUIRE, "agent");
            asm volatile("s_waitcnt vmcnt(0)" ::: "memory");
        }
    }
    __syncthreads();
}

#endif
#ifndef MK_BATCH
#define MK_BATCH 8
#endif
constexpr int BATCH = MK_BATCH, SEQ = 4096, DM = 1024, DEPTH = 4, DFF = 2816, NUP = 5632, NIN = 2048, NINF = 2056;
constexpr int M = BATCH * SEQ, NBH = BATCH * 4, NCH = SEQ / 64;
constexpr float EPS = 1e-6f, NEGF = -1e30f, LOG2E = 1.4426950408889634f;
constexpr size_t MiB = 1u << 20;
constexpr size_t WS_CTL = 0, CTL_ZERO_BYTES = 1 * MiB;
constexpr size_t WS_MOD = 1 * MiB;
constexpr size_t WS_GWT = 3 * MiB;
constexpr size_t WS_PWT = 3 * MiB + 256 * 1024;
constexpr size_t WS_WQT = 4 * MiB;
constexpr size_t WS_SM = 6 * MiB;
constexpr size_t SM_PRE = WS_SM, SM_POST = SM_PRE + 49152, SM_GATEB = SM_POST + 49152, SM_POOLS = SM_GATEB + 256, SM_CONVW = SM_POOLS + 4096, SM_CONVB = SM_CONVW + 32768, SM_NORMW = SM_CONVB + 8192, SM_SKIP = SM_NORMW + 8192;
constexpr size_t WS_WUP = 8 * MiB;
constexpr size_t WS_WDN = 96 * MiB;
constexpr size_t WS_WIN = 140 * MiB;
constexpr size_t WS_WOUT = 156 * MiB;
constexpr size_t WS_U = 164 * MiB;
constexpr size_t WS_Y = 228 * MiB;
constexpr size_t WS_BIG = 292 * MiB;
constexpr size_t WS_HID = WS_BIG;
constexpr size_t WS_Q16 = WS_BIG, WS_K16 = WS_BIG + 16 * MiB, WS_VT16 = WS_BIG + 32 * MiB, WS_PIN = WS_BIG + 48 * MiB;
constexpr size_t WS_XM = WS_BIG + 64 * MiB, WS_OG = WS_BIG + 96 * MiB, WS_XC = WS_BIG + 128 * MiB;
constexpr size_t WS_MQ = WS_BIG + 160 * MiB, WS_MK = WS_BIG + 192 * MiB, WS_MVT = WS_BIG + 224 * MiB;
constexpr size_t WS_DCT = WS_BIG + 256 * MiB;
constexpr size_t WS_HB = WS_BIG + 320 * MiB;
constexpr size_t WS_DN = WS_BIG + 384 * MiB;
constexpr size_t WS_GI = WS_BIG + 385 * MiB, WS_GF = WS_GI + 512 * 1024;
constexpr size_t WS_BCUM = WS_BIG + 386 * MiB;
constexpr size_t WS_BL = WS_BCUM + 512 * 1024, WS_AM = WS_BL + 8192, WS_MP = WS_AM + 8192;
constexpr size_t WIN_CS = 3 * MiB;
constexpr size_t WUP_SLOT = (size_t)NUP * 1024 * 2, WUP_CS = 8 * MiB;
constexpr size_t WS_END = WS_BIG + 388 * MiB;

typedef unsigned short bf16_t;
typedef short bf16x8 __attribute__((ext_vector_type(8)));
typedef float f32x4 __attribute__((ext_vector_type(4)));
typedef unsigned u32x4 __attribute__((ext_vector_type(4)));
typedef unsigned u32x2 __attribute__((ext_vector_type(2)));

struct Ctx { int wv, blk, nblk, vb; LAS unsigned char* lds; float* out; unsigned char* ws; };
#define PHASE_LOCALS const int lane = lnd(mk_lane_id()), wave = C.wv, tid = wave * 64 + lane, vblk = C.vb, gw = vblk * 8 + wave, ngw = C.nblk * 8; unsigned char* const ws = lndp(C.ws); (void)lane; (void)wave; (void)gw; (void)ngw; (void)ws;
enum { I_X = 0, I_C, I_ADAW, I_ADAB, I_PRE, I_POST, I_UP, I_DOWN, I_MIXIN, I_MIXOUT, I_POOLW, I_POOLS, I_CONVW, I_CONVB, I_QKVW, I_GATEB, I_NORMW, I_SKIP };

DEV float bf2f(unsigned b) { return __builtin_bit_cast(float, b << 16); }
DEV float bflo(unsigned w) { return __builtin_bit_cast(float, w << 16); }
DEV float bfhi(unsigned w) { return __builtin_bit_cast(float, w & 0xffff0000u); }
DEV bf16x8 mk8(unsigned a, unsigned b, unsigned c, unsigned d) { u32x4 w; w.x = a; w.y = b; w.z = c; w.w = d; return __builtin_bit_cast(bf16x8, w); }
DEV bf16x8 pack8(f32x4 a, f32x4 b) { return mk8(pk2(a[0], a[1]), pk2(a[2], a[3]), pk2(b[0], b[1]), pk2(b[2], b[3])); }
#ifdef EMU
DEV float wave_sum(float v) {
#pragma unroll
    for (int o = 1; o < 64; o <<= 1) v += __shfl_xor(v, o);
    return v; }
DEV float wave_max(float v) {
#pragma unroll
    for (int o = 1; o < 64; o <<= 1) v = fmaxf(v, __shfl_xor(v, o));
    return v; }
DEV float wave_prefix_sum(float v) { const int ln = mk_lane_id();
#pragma unroll
    for (int o = 1; o < 64; o <<= 1) { const float t = __shfl_up(v, o); if (ln >= o) v += t; }
    return v; }
DEV float lane63(float v) { return __shfl(v, 63); }
#else
template <int CTRL, int RM> DEV float dpp_add(float v) { return v + __builtin_bit_cast(float, __builtin_amdgcn_update_dpp(0, __builtin_bit_cast(int, v), CTRL, RM, 0xf, true)); }
DEV float wave_sum(float v) {
    v = dpp_add<0xB1, 0xf>(v); v = dpp_add<0x4E, 0xf>(v); v = dpp_add<0x141, 0xf>(v); v = dpp_add<0x140, 0xf>(v);
    v = dpp_add<0x142, 0xa>(v); v = dpp_add<0x143, 0xc>(v);
    return __builtin_bit_cast(float, __builtin_amdgcn_readlane(__builtin_bit_cast(int, v), 63)); }
template <int CTRL, int RM> DEV float dpp_max(float v) { return fmaxf(v, __builtin_bit_cast(float, __builtin_amdgcn_update_dpp(__builtin_bit_cast(int, v), __builtin_bit_cast(int, v), CTRL, RM, 0xf, false))); }
DEV float wave_max(float v) {
    v = dpp_max<0xB1, 0xf>(v); v = dpp_max<0x4E, 0xf>(v); v = dpp_max<0x141, 0xf>(v); v = dpp_max<0x140, 0xf>(v);
    v = dpp_max<0x142, 0xa>(v); v = dpp_max<0x143, 0xc>(v);
    return __builtin_bit_cast(float, __builtin_amdgcn_readlane(__builtin_bit_cast(int, v), 63)); }
template <int CTRL, int RM> DEV float dpp_add0(float v) { return v + __builtin_bit_cast(float, __builtin_amdgcn_update_dpp(0, __builtin_bit_cast(int, v), CTRL, RM, 0xf, false)); }
DEV float wave_prefix_sum(float v) {
    v = dpp_add0<0x111, 0xf>(v); v = dpp_add0<0x112, 0xf>(v); v = dpp_add0<0x114, 0xf>(v); v = dpp_add0<0x118, 0xf>(v);
    v = dpp_add0<0x142, 0xa>(v); v = dpp_add0<0x143, 0xc>(v); return v; }
DEV float lane63(float v) { return __builtin_bit_cast(float, __builtin_amdgcn_readlane(__builtin_bit_cast(int, v), 63)); }
#endif
DEV float quad_sum(float v) { v += __shfl_xor(v, 16); v += __shfl_xor(v, 32); return v; }
DEV float quad_max(float v) { v = fmaxf(v, __shfl_xor(v, 16)); v = fmaxf(v, __shfl_xor(v, 32)); return v; }
DEV float sigmoid_f(float x) { return fast_rcp(1.0f + __expf(-x)); }

DEV void phase_mod(Ctx& C, const float* c, const float* adaw, const float* adab) {
    PHASE_LOCALS
    float* mod = (float*)(ws + WS_MOD);
    LAS float* cact = (LAS float*)C.lds; LAS float* part = cact + BATCH * 1024;
    for (int i = tid; i < BATCH * 1024; i += 512) { const float v = c[i]; cact[i] = v * sigmoid_f(v); }
    __syncthreads();
    const int ks = tid >> 6, col = tid & 63;
    for (int u = C.blk; u < DEPTH * 9216 / 64; u += C.nblk) {
        const int n = u * 64 + col, l = n / 9216, nn = n % 9216;
        const float* w = adaw + ((size_t)l * 1024 + ks * 128) * 9216 + nn;
        float acc[BATCH];
#pragma unroll
        for (int b = 0; b < BATCH; ++b) acc[b] = 0.f;
#pragma unroll 4
        for (int k = 0; k < 128; ++k) { const float wv = w[(size_t)k * 9216];
#pragma unroll
            for (int b = 0; b < BATCH; ++b) acc[b] += cact[b * 1024 + ks * 128 + k] * wv; }
#pragma unroll
        for (int b = 0; b < BATCH; ++b) part[(ks * 64 + col) * BATCH + b] = acc[b];
        __syncthreads();
        for (int idx = tid; idx < BATCH * 64; idx += 512) { const int b = idx >> 6, cc = idx & 63; float s = 0.f;
#pragma unroll
            for (int k2 = 0; k2 < 8; ++k2) s += part[(k2 * 64 + cc) * BATCH + b];
            const int n2 = u * 64 + cc, l2 = n2 / 9216, nn2 = n2 % 9216;
            mod[((size_t)l2 * BATCH + b) * 9216 + nn2] = s + adab[l2 * 9216 + nn2]; }
        __syncthreads();
    }
}

DEV void transpose_item(const float* W, int pitch, int K, bf16_t* WT, int nblk, int item, int kind, LAS float* scr, int lane, float sc_gate = 1.0f, float sc_val = 1.0f) {
    const int kb = item / nblk, nb = item % nblk, k0 = 64 * kb, n0 = 32 * nb;
    int drow0 = n0;
    if (kind == 1) { const int t = n0 >= DFF ? 1 : 0, j = n0 - t * DFF; drow0 = 256 * (j >> 7) + 128 * t + (j & 127); }
    f32x4 wv4[8];
#pragma unroll
    for (int i = 0; i < 8; ++i) wv4[i] = *(const f32x4*)(W + (size_t)(k0 + 8 * i + (lane >> 3)) * pitch + n0 + 4 * (lane & 7));
#pragma unroll
    for (int i = 0; i < 8; ++i) { LAS float* d = scr + (8 * i + (lane >> 3)) * 33 + 4 * (lane & 7); d[0] = wv4[i][0]; d[1] = wv4[i][1]; d[2] = wv4[i][2]; d[3] = wv4[i][3]; }
    WAVE_LDS_SYNC();
    const int c = lane & 7;
#pragma unroll
    for (int j = 0; j < 4; ++j) { const int n = (lane >> 3) + 8 * j; const LAS float* s = scr + (8 * c) * 33 + n;
        if (kind == 2) {
            mk_u32x2 o8; o8.x = pk_fp8x4(s[0 * 33] * F8_SW, s[1 * 33] * F8_SW, s[2 * 33] * F8_SW, s[3 * 33] * F8_SW); o8.y = pk_fp8x4(s[4 * 33] * F8_SW, s[5 * 33] * F8_SW, s[6 * 33] * F8_SW, s[7 * 33] * F8_SW);
            *(mk_u32x2*)((unsigned char*)WT + (size_t)(drow0 + n) * K + k0 + 8 * c) = o8; continue; }
        if (kind == 1) { const float sc = n0 >= DFF ? sc_val : sc_gate;
            u32x4 o1; o1.x = pk2(s[0 * 33] * sc, s[1 * 33] * sc); o1.y = pk2(s[2 * 33] * sc, s[3 * 33] * sc); o1.z = pk2(s[4 * 33] * sc, s[5 * 33] * sc); o1.w = pk2(s[6 * 33] * sc, s[7 * 33] * sc);
            *(u32x4*)(WT + (size_t)(drow0 + n) * K + k0 + 8 * c) = o1; continue; }
        u32x4 o; o.x = pk2(s[0 * 33], s[1 * 33]); o.y = pk2(s[2 * 33], s[3 * 33]); o.z = pk2(s[4 * 33], s[5 * 33]); o.w = pk2(s[6 * 33], s[7 * 33]);
        *(u32x4*)(WT + (size_t)(drow0 + n) * K + k0 + 8 * c) = o; }
    WAVE_LDS_SYNC();
}
DEV void convert_up_i8(const float* W, unsigned char* W8, float* CS, int nb, float sc_gate, float sc_val, LAS float* scr, LAS float* smax, int wave, int lane, int pitch = NUP, bool plain = false) {
    const int n0 = 32 * nb, t = (!plain && n0 >= DFF) ? 1 : 0, j0 = n0 - t * DFF, drow0 = plain ? n0 : 256 * (j0 >> 7) + 128 * t + (j0 & 127);
    f32x4 wv[16];
#pragma unroll
    for (int i = 0; i < 16; ++i) wv[i] = *(const f32x4*)(W + (size_t)(128 * wave + 8 * i + (lane >> 3)) * pitch + n0 + 4 * (lane & 7));
    f32x4 cm = {0.f, 0.f, 0.f, 0.f};
#pragma unroll
    for (int i = 0; i < 16; ++i)
#pragma unroll
        for (int e = 0; e < 4; ++e) cm[e] = fmaxf(cm[e], fabsf(wv[i][e]));
#pragma unroll
    for (int e = 0; e < 4; ++e) { cm[e] = fmaxf(cm[e], __shfl_xor(cm[e], 8)); cm[e] = fmaxf(cm[e], __shfl_xor(cm[e], 16)); cm[e] = fmaxf(cm[e], __shfl_xor(cm[e], 32)); }
    if (lane < 8) { LAS float* d = smax + wave * 32 + 4 * lane; d[0] = cm[0]; d[1] = cm[1]; d[2] = cm[2]; d[3] = cm[3]; }
    __syncthreads();
    f32x4 am = {0.f, 0.f, 0.f, 0.f};
#pragma unroll
    for (int w2 = 0; w2 < 8; ++w2) { const LAS float* s = smax + w2 * 32 + 4 * (lane & 7);
#pragma unroll
        for (int e = 0; e < 4; ++e) am[e] = fmaxf(am[e], s[e]); }
    f32x4 inv;
#pragma unroll
    for (int e = 0; e < 4; ++e) inv[e] = am[e] > 0.f ? 127.0f / am[e] : 0.f;
    if (wave == 0 && lane < 8) { const float sc = (plain ? 1.0f : (t ? sc_val : sc_gate)) * (1.0f / 127.0f); *(f32x4*)(CS + t * DFF + j0 + 4 * lane) = am * sc; }
#pragma unroll
    for (int kb2 = 0; kb2 < 2; ++kb2) {
#pragma unroll
        for (int i = 0; i < 8; ++i) { LAS float* d = scr + (8 * i + (lane >> 3)) * 33 + 4 * (lane & 7); const f32x4 v = wv[8 * kb2 + i] * inv; d[0] = v[0]; d[1] = v[1]; d[2] = v[2]; d[3] = v[3]; }
        WAVE_LDS_SYNC();
        const int c = lane & 7;
#pragma unroll
        for (int j = 0; j < 4; ++j) { const int n = (lane >> 3) + 8 * j; const LAS float* s = scr + (8 * c) * 33 + n;
            mk_u32x2 o; o.x = pk_i8x4(s[0 * 33], s[1 * 33], s[2 * 33], s[3 * 33]); o.y = pk_i8x4(s[4 * 33], s[5 * 33], s[6 * 33], s[7 * 33]);
            *(mk_u32x2*)(W8 + (size_t)(drow0 + n) * 1024 + 128 * wave + 64 * kb2 + 8 * c) = o; }
        WAVE_LDS_SYNC();
    }
    __syncthreads();
}
constexpr int IT_UP = 16 * 176, IT_DN = 44 * 32, IT_IN = 16 * 64, IT_OUT = 16 * 32, IT_LAYER = 2 * IT_UP + 2 * IT_DN + IT_IN + IT_OUT;
struct CvtIn { const float *up, *down, *mixin, *mixout, *poolw, *qkvw, *pre, *post, *gateb, *pools, *convw, *convb, *normw, *skip; };
DEV void copy_f32(const float* src, float* dst, int n, int gt, int ngt) { for (int i = gt; i < n; i += ngt) dst[i] = src[i]; }
DEV void phase_convert(Ctx& C, const CvtIn& I) {
    PHASE_LOCALS
    LAS float* scr = (LAS float*)(C.lds + wave * 8704);
    if (MK_I8MASK) { LAS float* smax = (LAS float*)(C.lds + 8 * 8704);
        for (int hh = vblk; hh < DEPTH * 2 * 176; hh += C.nblk) { const int s = hh / 176, nb = hh % 176;
            if (!((MK_I8MASK >> s) & 1)) continue;
            convert_up_i8(I.up + (size_t)s * 1024 * NUP, ws + WS_WUP + (size_t)s * WUP_SLOT, (float*)(ws + WS_WUP + (size_t)s * WUP_SLOT + WUP_CS), nb, UPW_GATE, ((MK_F8MASK >> s) & 1) ? UPW_VAL * F8_SH : UPW_VAL, scr, smax, wave, lane); } }
    if (MK_I8IN) { LAS float* smax = (LAS float*)(C.lds + 8 * 8704);
        for (int hh = vblk; hh < DEPTH * 64; hh += C.nblk) { const int l = hh / 64, nb = hh % 64;
            convert_up_i8(I.mixin + (size_t)l * 1024 * NINF, ws + WS_WIN + (size_t)l * NIN * 1024 * 2, (float*)(ws + WS_WIN + (size_t)l * NIN * 1024 * 2 + WIN_CS), nb, 1.0f, 1.0f, scr, smax, wave, lane, NINF, true); } }
    for (int it = gw; it < DEPTH * IT_LAYER; it += ngw) {
        const int l = it / IT_LAYER; int r = it % IT_LAYER;
        if (r < 2 * IT_UP) { const int f = r / IT_UP; r -= f * IT_UP;
            if ((MK_I8MASK >> (l * 2 + f)) & 1) continue;
            transpose_item(I.up + (size_t)(l * 2 + f) * 1024 * NUP, NUP, 1024, (bf16_t*)(ws + WS_WUP) + (size_t)(l * 2 + f) * NUP * 1024, 176, r, 1, scr, lane, UPW_GATE, ((MK_F8MASK >> (l * 2 + f)) & 1) ? UPW_VAL * F8_SH : UPW_VAL); continue; }
        r -= 2 * IT_UP;
        if (r < 2 * IT_DN) { const int f = r / IT_DN; r -= f * IT_DN;
            transpose_item(I.down + (size_t)(l * 2 + f) * DFF * 1024, 1024, DFF, (bf16_t*)(ws + WS_WDN) + (size_t)(l * 2 + f) * 1024 * DFF, 32, r, ((MK_F8MASK >> (l * 2 + f)) & 1) ? 2 : 0, scr, lane); continue; }
        r -= 2 * IT_DN;
        if (r < IT_IN) { if (MK_I8IN) continue; transpose_item(I.mixin + (size_t)l * 1024 * NINF, NINF, 1024, (bf16_t*)(ws + WS_WIN) + (size_t)l * NIN * 1024, 64, r, 0, scr, lane); continue; }
        r -= IT_IN;
        transpose_item(I.mixout + (size_t)l * 1024 * 1024, 1024, 1024, (bf16_t*)(ws + WS_WOUT) + (size_t)l * 1024 * 1024, 32, r, 0, scr, lane);
    }
    const int gt = C.blk * 512 + tid, ngt = C.nblk * 512;
    bf16_t* pwt = (bf16_t*)(ws + WS_PWT); const float* pw = I.poolw;
    for (int i = gt; i < DEPTH * 4 * 64 * 64; i += ngt) { const int c = i & 63, e = (i >> 6) & 63, lg = i >> 12; pwt[i] = (bf16_t)f2bf(pw[((size_t)lg * 64 + c) * 64 + e]); }
    bf16_t* wqt = (bf16_t*)(ws + WS_WQT); const float* qw = I.qkvw;
    for (int i = gt; i < DEPTH * 3 * 4 * 128 * 128; i += ngt) { const int d = i & 127, e = (i >> 7) & 127, lwh = i >> 14; wqt[i] = (bf16_t)f2bf(qw[((size_t)lwh * 128 + d) * 128 + e]); }
    float* gwt = (float*)(ws + WS_GWT); const float* mi = I.mixin;
    for (int i = gt; i < DEPTH * 8 * 1024; i += ngt) { const int c = i & 1023, j = (i >> 10) & 7, l = i >> 13; gwt[i] = mi[((size_t)l * 1024 + c) * NINF + NIN + j]; }
    copy_f32(I.pre, (float*)(ws + SM_PRE), DEPTH * 3 * 1024, gt, ngt); copy_f32(I.post, (float*)(ws + SM_POST), DEPTH * 3 * 1024, gt, ngt); copy_f32(I.gateb, (float*)(ws + SM_GATEB), DEPTH * 8, gt, ngt);
    copy_f32(I.pools, (float*)(ws + SM_POOLS), DEPTH * 256, gt, ngt); copy_f32(I.convw, (float*)(ws + SM_CONVW), DEPTH * 4 * 512, gt, ngt); copy_f32(I.convb, (float*)(ws + SM_CONVB), DEPTH * 512, gt, ngt);
    copy_f32(I.normw, (float*)(ws + SM_NORMW), DEPTH * 512, gt, ngt); copy_f32(I.skip, (float*)(ws + SM_SKIP), DEPTH * 512, gt, ngt);
}

#ifndef MK_RESID_NT
#define MK_RESID_NT 3
#endif
#if (MK_RESID_NT & 1) && !defined(EMU)
#define RESID_LD(T, p) NT_LOAD(T, p)
#else
#define RESID_LD(T, p) (*(const T*)(p))
#endif
#if (MK_RESID_NT & 2) && !defined(EMU)
#define RESID_ST(T, p, v) NT_STORE(T, p, v)
#else
#define RESID_ST(T, p, v) (*(T*)(p) = (v))
#endif
#ifndef MK_RESID_NSTR
#define MK_RESID_NSTR 2
#endif
#ifndef MK_RESID_SPEC
#define MK_RESID_SPEC 1
#endif
#ifndef MK_RESID_INTER
#define MK_RESID_INTER 1
#endif
#ifndef RESID_AHEAD
#define RESID_AHEAD 1
#endif
#define RCOL(j) (8 * lane + 512 * ((j) >> 1) + 4 * ((j) & 1))
template <bool SRC32> DEV void resid_rows(const float* hsrc32, const bf16_t* HBr, const bf16_t* Y, float* out32, bf16_t* HBw, bf16_t* U, float* GI, float* GF, const float* gwt, const float* gb,
                                          const f32x4 (&A)[4], const f32x4 (&Bc)[4], const f32x4 (&Cc)[4], int rb, int rstr, int lane, bool final_out, bool has_y, bool has_next, bool gates, float yeps, bool u8, float* RS) {
    constexpr int NS = SRC32 ? 1 : RESID_AHEAD;
    f32x4 hn32[NS][2][4]; u32x4 hn16[NS][2][2], yn[NS][2][2];
#define RESID_LOAD(st, sl, r_) do { _Pragma("unroll") for (int pp = 0; pp < 2; ++pp) { const size_t o_ = (size_t)(r_) * 1024 + 8 * lane + 512 * pp; \
        if (SRC32) { hn32[st][sl][2 * pp] = *(const f32x4*)(hsrc32 + o_); hn32[st][sl][2 * pp + 1] = *(const f32x4*)(hsrc32 + o_ + 4); } else hn16[st][sl][pp] = RESID_LD(u32x4, HBr + o_); \
        if (has_y) yn[st][sl][pp] = RESID_LD(u32x4, Y + o_); } } while (0)
#define RESID_UNPK(dst, src_) do { const u32x4 t_ = (src_); dst[0] = (f32x4){bflo(t_.x), bfhi(t_.x), bflo(t_.y), bfhi(t_.y)}; dst[1] = (f32x4){bflo(t_.z), bfhi(t_.z), bflo(t_.w), bfhi(t_.w)}; } while (0)
#pragma unroll
    for (int st = 0; st < NS; ++st) { RESID_LOAD(st, 0, rb + rstr * st); RESID_LOAD(st, 1, rb + rstr * (8 + st)); }
    for (int k2 = 0; k2 < 8; k2 += NS) {
#pragma unroll
      for (int st = 0; st < NS; ++st) { const int k = k2 + st;
        f32x4 h[2][4]; u32x4 yw[2][2];
#pragma unroll
        for (int sl = 0; sl < 2; ++sl)
#pragma unroll
            for (int pp = 0; pp < 2; ++pp) { if (SRC32) { h[sl][2 * pp] = hn32[st][sl][2 * pp]; h[sl][2 * pp + 1] = hn32[st][sl][2 * pp + 1]; } else RESID_UNPK((&h[sl][2 * pp]), hn16[st][sl][pp]); yw[sl][pp] = yn[st][sl][pp]; }
        const int kn = k + NS < 8 ? k + NS : 7;
        RESID_LOAD(st, 0, rb + rstr * kn); RESID_LOAD(st, 1, rb + rstr * (8 + kn));
#pragma unroll
        for (int sl = 0; sl < 2; ++sl) { const int row = rb + rstr * (8 * sl + k);
            if (has_y) {
                f32x4 y[4]; float ss = 0.f;
#pragma unroll
                for (int pp = 0; pp < 2; ++pp) RESID_UNPK((&y[2 * pp]), yw[sl][pp]);
#pragma unroll
                for (int j = 0; j < 4; ++j) ss += (y[j][0] * y[j][0] + y[j][1] * y[j][1]) + (y[j][2] * y[j][2] + y[j][3] * y[j][3]);
                const float rs = rsqrtf(wave_sum(ss) * (1.0f / 1024.0f) + yeps);
#pragma unroll
                for (int j = 0; j < 4; ++j) { h[sl][j] = h[sl][j] + A[j] * y[j] * rs; if (final_out) *(f32x4*)(out32 + (size_t)row * 1024 + RCOL(j)) = h[sl][j]; }
                if (!final_out) {
#pragma unroll
                    for (int pp = 0; pp < 2; ++pp) { u32x4 w; w.x = pk2(h[sl][2 * pp][0], h[sl][2 * pp][1]); w.y = pk2(h[sl][2 * pp][2], h[sl][2 * pp][3]); w.z = pk2(h[sl][2 * pp + 1][0], h[sl][2 * pp + 1][1]); w.w = pk2(h[sl][2 * pp + 1][2], h[sl][2 * pp + 1][3]);
                        RESID_ST(u32x4, HBw + (size_t)row * 1024 + 8 * lane + 512 * pp, w); } }
            }
            if (has_next) {
                float ss = 0.f;
#pragma unroll
                for (int j = 0; j < 4; ++j) ss += (h[sl][j][0] * h[sl][j][0] + h[sl][j][1] * h[sl][j][1]) + (h[sl][j][2] * h[sl][j][2] + h[sl][j][3] * h[sl][j][3]);
                const float rs = rsqrtf(wave_sum(ss) * (1.0f / 1024.0f) + EPS);
#pragma unroll
                for (int j = 0; j < 4; ++j) h[sl][j] = h[sl][j] * rs * Bc[j] + Cc[j];
                if (u8) {
                    float am = 0.f;
#pragma unroll
                    for (int j = 0; j < 4; ++j) am = fmaxf(fmaxf(am, fmaxf(fabsf(h[sl][j][0]), fabsf(h[sl][j][1]))), fmaxf(fabsf(h[sl][j][2]), fabsf(h[sl][j][3])));
                    am = wave_max(am); const float inv = am > 0.f ? 127.0f * fast_rcp(am) : 0.f;
#pragma unroll
                    for (int pp = 0; pp < 2; ++pp) { mk_u32x2 w; w.x = pk_i8x4s(h[sl][2 * pp][0], h[sl][2 * pp][1], h[sl][2 * pp][2], h[sl][2 * pp][3], inv); w.y = pk_i8x4s(h[sl][2 * pp + 1][0], h[sl][2 * pp + 1][1], h[sl][2 * pp + 1][2], h[sl][2 * pp + 1][3], inv);
                        *(mk_u32x2*)((unsigned char*)U + u8_row(row) + 8 * lane + 512 * pp) = w; }
                    if (lane == 0) *(float*)((unsigned char*)U + u8_rs(row)) = am * (1.0f / 127.0f);
                } else {
#pragma unroll
                    for (int pp = 0; pp < 2; ++pp) { u32x4 w; w.x = pk2(h[sl][2 * pp][0], h[sl][2 * pp][1]); w.y = pk2(h[sl][2 * pp][2], h[sl][2 * pp][3]); w.z = pk2(h[sl][2 * pp + 1][0], h[sl][2 * pp + 1][1]); w.w = pk2(h[sl][2 * pp + 1][2], h[sl][2 * pp + 1][3]);
                        *(u32x4*)(U + (size_t)row * 1024 + 8 * lane + 512 * pp) = w; }
                }
                if (gates) {
#pragma unroll 2
                    for (int g = 0; g < 8; ++g) { float d = 0.f;
#pragma unroll
                        for (int j = 0; j < 4; ++j) { const f32x4 wv = *(const f32x4*)(gwt + g * 1024 + RCOL(j)); d += (h[sl][j][0] * wv[0] + h[sl][j][1] * wv[1]) + (h[sl][j][2] * wv[2] + h[sl][j][3] * wv[3]); }
                        d = wave_sum(d) + gb[g];
                        if (lane == 0) { if (g < 4) GI[(size_t)g * M + row] = d; else GF[(size_t)(g - 4) * M + row] = d; } }
                }
            }
        }
      }
    }
#undef RESID_LOAD
#undef RESID_UNPK
}
template <bool SRC32, bool HAS_Y, bool HAS_NEXT, bool U8, bool GATES>
DEV void resid_rows_t(const float* hsrc32, const bf16_t* HBr, const bf16_t* Y, float* out32, bf16_t* HBw, bf16_t* U, float* GI, float* GF, const float* gwt, const float* gb,
                      const f32x4 (&A)[4], const f32x4 (&Bc)[4], const f32x4 (&Cc)[4], int rb, int rstr, int lane, float yeps, const LAS u32x4* gql) {
    constexpr bool FINAL = !HAS_NEXT;
    constexpr int NSTR = (SRC32 || GATES) ? 2 : MK_RESID_NSTR, NSTEP = 16 / NSTR;
    f32x4 hn32[NSTR][4]; u32x4 hn16[NSTR][2], yn[NSTR][2];
#define RT_LOAD(sl, r_) do { _Pragma("unroll") for (int pp = 0; pp < 2; ++pp) { const size_t o_ = (size_t)(r_) * 1024 + 8 * lane + 512 * pp; \
        if (SRC32) { hn32[sl][2 * pp] = *(const f32x4*)(hsrc32 + o_); hn32[sl][2 * pp + 1] = *(const f32x4*)(hsrc32 + o_ + 4); } else hn16[sl][pp] = RESID_LD(u32x4, HBr + o_); \
        if (HAS_Y) yn[sl][pp] = RESID_LD(u32x4, Y + o_); } } while (0)
#define RT_UNPK(dst, src_) do { const u32x4 t_ = (src_); dst[0] = (f32x4){bflo(t_.x), bfhi(t_.x), bflo(t_.y), bfhi(t_.y)}; dst[1] = (f32x4){bflo(t_.z), bfhi(t_.z), bflo(t_.w), bfhi(t_.w)}; } while (0)
#define RT_SUMSQ(v) (((v)[0][0] * (v)[0][0] + (v)[0][1] * (v)[0][1]) + ((v)[0][2] * (v)[0][2] + (v)[0][3] * (v)[0][3]) + ((v)[1][0] * (v)[1][0] + (v)[1][1] * (v)[1][1]) + ((v)[1][2] * (v)[1][2] + (v)[1][3] * (v)[1][3]) \
                   + ((v)[2][0] * (v)[2][0] + (v)[2][1] * (v)[2][1]) + ((v)[2][2] * (v)[2][2] + (v)[2][3] * (v)[2][3]) + ((v)[3][0] * (v)[3][0] + (v)[3][1] * (v)[3][1]) + ((v)[3][2] * (v)[3][2] + (v)[3][3] * (v)[3][3]))
#pragma unroll
    for (int sl = 0; sl < NSTR; ++sl) RT_LOAD(sl, rb + rstr * (sl * NSTEP));
    for (int k = 0; k < NSTEP; ++k) {
        f32x4 h[NSTR][4], y[NSTR][4]; int row[NSTR]; float q[NSTR], r_[NSTR];
#pragma unroll
        for (int sl = 0; sl < NSTR; ++sl) { row[sl] = rb + rstr * (sl * NSTEP + k);
#pragma unroll
            for (int pp = 0; pp < 2; ++pp) { if (SRC32) { h[sl][2 * pp] = hn32[sl][2 * pp]; h[sl][2 * pp + 1] = hn32[sl][2 * pp + 1]; } else RT_UNPK((&h[sl][2 * pp]), hn16[sl][pp]); if (HAS_Y) RT_UNPK((&y[sl][2 * pp]), yn[sl][pp]); } }
        const int kn = k + 1 < NSTEP ? k + 1 : NSTEP - 1;
#pragma unroll
        for (int sl = 0; sl < NSTR; ++sl) RT_LOAD(sl, rb + rstr * (sl * NSTEP + kn));
        if (HAS_Y) {
#pragma unroll
            for (int sl = 0; sl < NSTR; ++sl) q[sl] = RT_SUMSQ(y[sl]);
#pragma unroll
            for (int sl = 0; sl < NSTR; ++sl) q[sl] = wave_sum(q[sl]);
#pragma unroll
            for (int sl = 0; sl < NSTR; ++sl) r_[sl] = rsqrtf(q[sl] * (1.0f / 1024.0f) + yeps);
#pragma unroll
            for (int sl = 0; sl < NSTR; ++sl) {
#pragma unroll
                for (int j = 0; j < 4; ++j) h[sl][j] = h[sl][j] + A[j] * y[sl][j] * r_[sl];
                if (FINAL) {
#pragma unroll
                    for (int j = 0; j < 4; ++j) *(f32x4*)(out32 + (size_t)row[sl] * 1024 + RCOL(j)) = h[sl][j];
                } else {
#pragma unroll
                    for (int pp = 0; pp < 2; ++pp) { u32x4 w; w.x = pk2(h[sl][2 * pp][0], h[sl][2 * pp][1]); w.y = pk2(h[sl][2 * pp][2], h[sl][2 * pp][3]); w.z = pk2(h[sl][2 * pp + 1][0], h[sl][2 * pp + 1][1]); w.w = pk2(h[sl][2 * pp + 1][2], h[sl][2 * pp + 1][3]);
                        RESID_ST(u32x4, HBw + (size_t)row[sl] * 1024 + 8 * lane + 512 * pp, w); } } }
        }
        if (HAS_NEXT) {
#pragma unroll
            for (int sl = 0; sl < NSTR; ++sl) q[sl] = RT_SUMSQ(h[sl]);
#pragma unroll
            for (int sl = 0; sl < NSTR; ++sl) q[sl] = wave_sum(q[sl]);
#pragma unroll
            for (int sl = 0; sl < NSTR; ++sl) { r_[sl] = rsqrtf(q[sl] * (1.0f / 1024.0f) + EPS);
#pragma unroll
                for (int j = 0; j < 4; ++j) h[sl][j] = h[sl][j] * r_[sl] * Bc[j] + Cc[j]; }
            if (U8) {
                float am[NSTR];
#pragma unroll
                for (int sl = 0; sl < NSTR; ++sl) { am[sl] = 0.f;
#pragma unroll
                    for (int j = 0; j < 4; ++j) am[sl] = fmaxf(fmaxf(am[sl], fmaxf(fabsf(h[sl][j][0]), fabsf(h[sl][j][1]))), fmaxf(fabsf(h[sl][j][2]), fabsf(h[sl][j][3]))); }
#pragma unroll
                for (int sl = 0; sl < NSTR; ++sl) am[sl] = wave_max(am[sl]);
#pragma unroll
                for (int sl = 0; sl < NSTR; ++sl) { const float inv = am[sl] > 0.f ? 127.0f * fast_rcp(am[sl]) : 0.f;
#pragma unroll
                    for (int pp = 0; pp < 2; ++pp) { mk_u32x2 w; w.x = pk_i8x4s(h[sl][2 * pp][0], h[sl][2 * pp][1], h[sl][2 * pp][2], h[sl][2 * pp][3], inv); w.y = pk_i8x4s(h[sl][2 * pp + 1][0], h[sl][2 * pp + 1][1], h[sl][2 * pp + 1][2], h[sl][2 * pp + 1][3], inv);
                        *(mk_u32x2*)((unsigned char*)U + u8_row(row[sl]) + 8 * lane + 512 * pp) = w; }
                    *(float*)((unsigned char*)U + u8_rs(row[sl])) = am[sl] * (1.0f / 127.0f); }
            } else {
#pragma unroll
                for (int sl = 0; sl < NSTR; ++sl) {
#pragma unroll
                    for (int pp = 0; pp < 2; ++pp) { u32x4 w; w.x = pk2(h[sl][2 * pp][0], h[sl][2 * pp][1]); w.y = pk2(h[sl][2 * pp][2], h[sl][2 * pp][3]); w.z = pk2(h[sl][2 * pp + 1][0], h[sl][2 * pp + 1][1]); w.w = pk2(h[sl][2 * pp + 1][2], h[sl][2 * pp + 1][3]);
                        *(u32x4*)(U + (size_t)row[sl] * 1024 + 8 * lane + 512 * pp) = w; } }
            }
            if (GATES && !SRC32) {
                unsigned hp[2][8];
#pragma unroll
                for (int sl = 0; sl < 2; ++sl)
#pragma unroll
                    for (int j = 0; j < 4; ++j) { hp[sl][2 * j] = pk2(h[sl][j][0], h[sl][j][1]); hp[sl][2 * j + 1] = pk2(h[sl][j][2], h[sl][j][3]); }
#pragma unroll 2
                for (int g = 0; g < 8; ++g) { float d0 = 0.f, d1 = 0.f;
                    const u32x4 w0 = gql[(g * 64 + lane) * 2], w1 = gql[(g * 64 + lane) * 2 + 1]; const unsigned wq[8] = {w0.x, w0.y, w0.z, w0.w, w1.x, w1.y, w1.z, w1.w};
#pragma unroll
                    for (int t = 0; t < 8; ++t) { d0 = dot2bf(hp[0][t], wq[t], d0); d1 = dot2bf(hp[1][t], wq[t], d1); }
                    d0 = wave_sum(d0) + gb[g]; d1 = wave_sum(d1) + gb[g];
                    float* gp = g < 4 ? GI + (size_t)g * M : GF + (size_t)(g - 4) * M; gp[row[0]] = d0; gp[row[1]] = d1; }
            }
            if (GATES && SRC32) {
#pragma unroll 2
                for (int g = 0; g < 8; ++g) { float d0 = 0.f, d1 = 0.f;
#pragma unroll
                    for (int j = 0; j < 4; ++j) { const f32x4 wv = *(const f32x4*)(gwt + g * 1024 + RCOL(j));
                        d0 += (h[0][j][0] * wv[0] + h[0][j][1] * wv[1]) + (h[0][j][2] * wv[2] + h[0][j][3] * wv[3]); d1 += (h[1][j][0] * wv[0] + h[1][j][1] * wv[1]) + (h[1][j][2] * wv[2] + h[1][j][3] * wv[3]); }
                    d0 = wave_sum(d0) + gb[g]; d1 = wave_sum(d1) + gb[g];
                    float* gp = g < 4 ? GI + (size_t)g * M : GF + (size_t)(g - 4) * M; gp[row[0]] = d0; gp[row[1]] = d1; }
            }
        }
    }
#undef RT_LOAD
#undef RT_UNPK
#undef RT_SUMSQ
}
DEV void phase_resid(Ctx& C, const float* hsrc32, bool final_out, const float* prew, const float* postw, const float* gateb, bool has_y, float wgt, int lpost, int spost, bool has_next, int lnext, int snext, bool gates, float yeps = EPS, bool u8 = false) {
    PHASE_LOCALS
    const float* mod = (const float*)(ws + WS_MOD);
    const bf16_t* Y = (const bf16_t*)(ws + WS_Y); bf16_t* U = (bf16_t*)(ws + WS_U); bf16_t* HB = (bf16_t*)(ws + WS_HB);
    const float* gwt = (const float*)(ws + WS_GWT) + (size_t)lnext * 8 * 1024; const float* gb = gateb + lnext * 8;
    float* GI = (float*)(ws + WS_GI); float* GF = (float*)(ws + WS_GF); float* RS = nullptr;
    LAS u32x4* gql = (LAS u32x4*)C.lds;
    if (gates && !hsrc32 && MK_RESID_SPEC) {
#pragma unroll
        for (int g = 0; g < 8; ++g) { u32x4 q0, q1; const f32x4 a0 = *(const f32x4*)(gwt + g * 1024 + RCOL(0)), a1 = *(const f32x4*)(gwt + g * 1024 + RCOL(1)), a2 = *(const f32x4*)(gwt + g * 1024 + RCOL(2)), a3 = *(const f32x4*)(gwt + g * 1024 + RCOL(3));
            q0.x = pk2(a0[0], a0[1]); q0.y = pk2(a0[2], a0[3]); q0.z = pk2(a1[0], a1[1]); q0.w = pk2(a1[2], a1[3]); q1.x = pk2(a2[0], a2[1]); q1.y = pk2(a2[2], a2[3]); q1.z = pk2(a3[0], a3[1]); q1.w = pk2(a3[2], a3[3]);
            gql[(g * 64 + lane) * 2] = q0; gql[(g * 64 + lane) * 2 + 1] = q1; }
        __syncthreads();
    }
    const bool inter = MK_RESID_INTER && (ngw & 255) == 0 && (SEQ == 4096);
    const int nslab = inter ? M / 4096 : M / 16, sstep = inter ? (ngw >> 8) : ngw;
    for (int sidx = inter ? (gw >> 8) : gw; sidx < nslab; sidx += sstep) {
        const int rb = inter ? sidx * 4096 + (gw & 255) : sidx * 16, rstr = inter ? 256 : 1;
        const int b = rb / SEQ;
        f32x4 A[4], Bc[4], Cc[4];
#pragma unroll
        for (int j = 0; j < 4; ++j) { const int c = RCOL(j); A[j] = Bc[j] = Cc[j] = (f32x4){0.f, 0.f, 0.f, 0.f};
            if (has_y) { const float* mp = mod + ((size_t)lpost * BATCH + b) * 9216 + spost * 3072; A[j] = *(const f32x4*)(mp + 2048 + c) * *(const f32x4*)(postw + (lpost * 3 + spost) * 1024 + c) * wgt; }
            if (has_next) { const float* mn = mod + ((size_t)lnext * BATCH + b) * 9216 + snext * 3072; Bc[j] = *(const f32x4*)(prew + (lnext * 3 + snext) * 1024 + c) * (*(const f32x4*)(mn + 1024 + c) + 1.0f); Cc[j] = *(const f32x4*)(mn + c); } }
#define RR_T(S_, Y_, N_, U_, G_) resid_rows_t<S_, Y_, N_, U_, G_>(hsrc32, HB, Y, C.out, HB, U, GI, GF, gwt, gb, A, Bc, Cc, rb, rstr, lane, yeps, gql)
        const bool fin = final_out && !has_next;
        if (MK_RESID_SPEC && hsrc32 && !has_y && has_next && !gates && !final_out) { if (u8) RR_T(true, false, true, true, false); else RR_T(true, false, true, false, false); }
        else if (MK_RESID_SPEC && hsrc32 && has_y && has_next && gates && !u8 && !final_out) RR_T(true, true, true, false, true);
        else if (MK_RESID_SPEC && !hsrc32 && has_y && has_next && !gates && !final_out) { if (u8) RR_T(false, true, true, true, false); else RR_T(false, true, true, false, false); }
        else if (MK_RESID_SPEC && !hsrc32 && has_y && has_next && gates && !u8 && !final_out) RR_T(false, true, true, false, true);
        else if (MK_RESID_SPEC && !hsrc32 && has_y && fin) RR_T(false, true, false, false, false);
        else if (hsrc32) resid_rows<true>(hsrc32, HB, Y, C.out, HB, U, GI, GF, gwt, gb, A, Bc, Cc, rb, rstr, lane, final_out, has_y, has_next, gates, yeps, u8, RS);
        else resid_rows<false>(hsrc32, HB, Y, C.out, HB, U, GI, GF, gwt, gb, A, Bc, Cc, rb, rstr, lane, final_out, has_y, has_next, gates, yeps, u8, RS);
#undef RR_T
    }
}

DEV int xcd_deal(int w, int k, int W, int N) { const int w8 = W >> 3; return (w / w8) * (N >> 3) + k * w8 + (w % w8); }
struct AttnBlk { bf16x8 k[4]; u32x2 v[8]; };
DEV int attn_nb(int rp, int r, int maxb) { const int n = rp == r ? 5 : (((rp - r) & 3) == 0 ? 2 : 1); return n < maxb ? n : maxb; }
DEV void attn_load(AttnBlk& B, const bf16_t* Kbh, const bf16_t* Vbh, int rp, int jk0, int qi, int g) {
    const bf16_t* kc = Kbh + (size_t)rp * 256 * 64; const bf16_t* vc = Vbh + (size_t)rp * 64 * 256;
#pragma unroll
    for (int kb = 0; kb < 2; ++kb) { int jr = jk0 + 16 * kb + qi; jr = jr < 0 ? 0 : jr; const bf16_t* kp = kc + (size_t)(jr >> 4) * 1024 + (jr & 15) * 32 + 8 * g;
        B.k[2 * kb] = *(const bf16x8*)kp; B.k[2 * kb + 1] = *(const bf16x8*)(kp + 512);
        int jt = (jk0 >> 4) + kb; jt = jt < 0 ? 0 : jt; const bf16_t* vp = vc + (size_t)jt * 1024 + qi * 16 + 4 * g;
#pragma unroll
        for (int dg = 0; dg < 4; ++dg) B.v[2 * dg + kb] = *(const u32x2*)(vp + dg * 256); }
}
DEV void attn_bounds(int rp, int jkb, int r, int jq, int g, unsigned& bmax, unsigned& bA, unsigned& bB, int& u0, bool live = true) {
    const int dr = r - rp, x0 = dr < 0 ? 1 : 0, n1 = ((128 - dr) >> 4) - x0 + 1, n2 = ((512 - dr) >> 4) - x0 + 1, n3 = ((2048 - dr) >> 4) - x0 + 1;
    const bool c16 = dr == 0, c4 = (dr & 3) == 0;
    const int nj = live ? jq - x0 + 1 : 0;
    const int mx = c16 ? n3 : (c4 ? n2 : n1), a = c4 ? n1 : 0, b = c16 ? n2 : 0;
    bmax = (unsigned)(mx < nj ? mx : nj); bA = (unsigned)(a < nj ? a : nj); bB = (unsigned)(b < nj ? b : nj);
    u0 = jq - jkb - x0 - 4 * g;
}
DEV void attn_compute(const AttnBlk& B, int rp, int jk0, int r, int jq, int g, bf16x8 qf0, bf16x8 qf1, f32x4 (&o)[4], float& mrun, float& lrun) {
    f32x4 st[2];
#pragma unroll
    for (int kb = 0; kb < 2; ++kb) { st[kb] = mfma16(B.k[2 * kb], qf0, (f32x4){0.f, 0.f, 0.f, 0.f}); st[kb] = mfma16(B.k[2 * kb + 1], qf1, st[kb]); }
    float cm[2][4], s2[2][4]; float bm = NEGF;
    unsigned bmax, bA, bB; int u0; attn_bounds(rp, jk0, r, jq, g, bmax, bA, bB, u0);
#pragma unroll
    for (int kb = 0; kb < 2; ++kb)
#pragma unroll
        for (int i = 0; i < 4; ++i) { const unsigned u = (unsigned)(u0 - 16 * kb - i);
            cm[kb][i] = (u < bmax ? 1.f : 0.f) + (u < bA ? 1.f : 0.f) + (u < bB ? 1.f : 0.f); s2[kb][i] = u < bmax ? st[kb][i] : NEGF; bm = fmaxf(bm, s2[kb][i]); }
    bm = quad_max(bm);
    const float mnew = fmaxf(mrun, bm), alpha = fast_exp2(mrun - mnew); mrun = mnew;
    float p[2][4], ps = 0.f;
#pragma unroll
    for (int kb = 0; kb < 2; ++kb)
#pragma unroll
        for (int i = 0; i < 4; ++i) { p[kb][i] = cm[kb][i] * fast_exp2(s2[kb][i] - mnew); ps += p[kb][i]; }
    lrun = lrun * alpha + ps;
    const bf16x8 pf = mk8(pk2(p[0][0], p[0][1]), pk2(p[0][2], p[0][3]), pk2(p[1][0], p[1][1]), pk2(p[1][2], p[1][3]));
#pragma unroll
    for (int dg = 0; dg < 4; ++dg) o[dg] = mfma16(mk8(B.v[2 * dg].x, B.v[2 * dg].y, B.v[2 * dg + 1].x, B.v[2 * dg + 1].y), pf, o[dg] * alpha);
}
DEV void attn_compute2(const AttnBlk& B0, int rp0, int jk0, const AttnBlk& B1, int rp1, int jk1, int r, int jq, int g, bf16x8 qf0, bf16x8 qf1, f32x4 (&o)[4], float& mrun, float& lrun, bool live0 = true, bool live1 = true) {
    f32x4 st[2][2];
#pragma unroll
    for (int kb = 0; kb < 2; ++kb) { st[0][kb] = mfma16(B0.k[2 * kb], qf0, (f32x4){0.f, 0.f, 0.f, 0.f}); st[1][kb] = mfma16(B1.k[2 * kb], qf0, (f32x4){0.f, 0.f, 0.f, 0.f}); }
#pragma unroll
    for (int kb = 0; kb < 2; ++kb) { st[0][kb] = mfma16(B0.k[2 * kb + 1], qf1, st[0][kb]); st[1][kb] = mfma16(B1.k[2 * kb + 1], qf1, st[1][kb]); }
    float cm[2][2][4], s2[2][2][4]; float bm = NEGF;
#pragma unroll
    for (int bi = 0; bi < 2; ++bi) { const int rp = bi ? rp1 : rp0, jkb = bi ? jk1 : jk0;
        unsigned bmax, bA, bB; int u0; attn_bounds(rp, jkb, r, jq, g, bmax, bA, bB, u0, bi ? live1 : live0);
#pragma unroll
        for (int kb = 0; kb < 2; ++kb)
#pragma unroll
            for (int i = 0; i < 4; ++i) { const unsigned u = (unsigned)(u0 - 16 * kb - i);
                cm[bi][kb][i] = (u < bmax ? 1.f : 0.f) + (u < bA ? 1.f : 0.f) + (u < bB ? 1.f : 0.f); s2[bi][kb][i] = u < bmax ? st[bi][kb][i] : NEGF; bm = fmaxf(bm, s2[bi][kb][i]); } }
    bm = quad_max(bm);
    const float mnew = fmaxf(mrun, bm), alpha = fast_exp2(mrun - mnew); mrun = mnew;
    float p[2][2][4], ps = 0.f;
#pragma unroll
    for (int bi = 0; bi < 2; ++bi)
#pragma unroll
        for (int kb = 0; kb < 2; ++kb)
#pragma unroll
            for (int i = 0; i < 4; ++i) { p[bi][kb][i] = cm[bi][kb][i] * fast_exp2(s2[bi][kb][i] - mnew); ps += p[bi][kb][i]; }
    lrun = lrun * alpha + ps;
    const bf16x8 pf0 = mk8(pk2(p[0][0][0], p[0][0][1]), pk2(p[0][0][2], p[0][0][3]), pk2(p[0][1][0], p[0][1][1]), pk2(p[0][1][2], p[0][1][3]));
    const bf16x8 pf1 = mk8(pk2(p[1][0][0], p[1][0][1]), pk2(p[1][0][2], p[1][0][3]), pk2(p[1][1][0], p[1][1][1]), pk2(p[1][1][2], p[1][1][3]));
#pragma unroll
    for (int dg = 0; dg < 4; ++dg) { o[dg] = mfma16(mk8(B0.v[2 * dg].x, B0.v[2 * dg].y, B0.v[2 * dg + 1].x, B0.v[2 * dg + 1].y), pf0, o[dg] * alpha);
        o[dg] = mfma16(mk8(B1.v[2 * dg].x, B1.v[2 * dg].y, B1.v[2 * dg + 1].x, B1.v[2 * dg + 1].y), pf1, o[dg]); }
}
#ifndef MK_ATTN_FLAT
#define MK_ATTN_FLAT 0
#endif
#define ATTN_GEN(orp, ojk) do { ++gblk; if (grp < 16 && gblk >= attn_nb(grp, r, maxb)) { ++grp; gblk = 0; } const bool _v = grp < 16; orp = _v ? grp : 0; ojk = _v ? j0 + 16 - 32 * (gblk + 1) : j0 - 16; } while (0)
#ifndef MK_ATTN_DUAL
#define MK_ATTN_DUAL 3
#endif
DEV void attn_gen(int& grp, int& gblk, int r, int maxb, int j0, int& orp, int& ojk) { ++gblk; if (grp < 16 && gblk >= attn_nb(grp, r, maxb)) { ++grp; gblk = 0; } const bool v_ = grp < 16; orp = v_ ? grp : 0; ojk = v_ ? j0 + 16 - 32 * (gblk + 1) : j0 - 16; }
#define ATTN_UNIT_SETUP(X, kit_) \
        const int u##X = xdeal ? xcd_deal(gw, (kit_), ngw, NBH * 256) : u0 + ((kit_) - kit) * ngw; \
        const int bh##X = u##X >> 8, r##X = (u##X >> 4) & 15, jb##X = ((u##X & 15) + 5 * (kit_)) & 15, j0##X = 16 * jb##X, b##X = bh##X >> 2, hd##X = bh##X & 3; \
        const bf16_t* qp##X = Q16 + ((size_t)bh##X * 16 + r##X) * 256 * 64 + (size_t)jb##X * 1024 + qi * 32 + 8 * g; \
        const bf16x8 qf0##X = *(const bf16x8*)qp##X, qf1##X = *(const bf16x8*)(qp##X + 512); \
        const bf16_t* Kbh##X = K16 + (size_t)bh##X * 16 * 256 * 64; const bf16_t* Vbh##X = VT16 + (size_t)bh##X * 16 * 64 * 256; \
        f32x4 o##X[4]; _Pragma("unroll") for (int dg = 0; dg < 4; ++dg) o##X[dg] = (f32x4){0.f, 0.f, 0.f, 0.f}; \
        float mrun##X = NEGF, lrun##X = 0.f; \
        const int jq##X = j0##X + qi, maxb##X = (j0##X + 47) >> 5; \
        const int T##X = attn_nb(r##X, r##X, maxb##X) + 3 * attn_nb((r##X + 4) & 15, r##X, maxb##X) + 12; \
        int grp##X = 0, gblk##X = -1;
#define ATTN_UNIT_STORE(X) do { const float linv = fast_rcp(quad_sum(lrun##X)); const int s_ = 16 * jq##X + r##X; bf16_t* op = MIX + ((size_t)b##X * SEQ + s_) * 1024 + 64 * hd##X + 4 * g; \
        _Pragma("unroll") for (int dg = 0; dg < 4; ++dg) { const f32x4 v = o##X[dg] * linv; u32x2 w; w.x = pk2(v[0], v[1]); w.y = pk2(v[2], v[3]); *(u32x2*)(op + 16 * dg) = w; } } while (0)
DEV void phase_attn_dual(Ctx& C) {
    PHASE_LOCALS
    const bf16_t* Q16 = (const bf16_t*)(ws + WS_Q16); const bf16_t* K16 = (const bf16_t*)(ws + WS_K16); const bf16_t* VT16 = (const bf16_t*)(ws + WS_VT16);
    bf16_t* MIX = (bf16_t*)(ws + WS_U);
    const int qi = lane & 15, g = lane >> 4;
    const bool xdeal = ((ngw & 7) == 0) && ((NBH * 256) % ngw == 0);
    for (int kit = 0, u0 = gw; u0 < NBH * 256; kit += 2, u0 += 2 * ngw) {
        ATTN_UNIT_SETUP(A, kit)
        ATTN_UNIT_SETUP(B, kit + 1)
        const int Tm = TA > TB ? TA : TB;
        for (int t = 0; t < Tm; t += 2) {
            AttnBlk a0, a1, c0, c1; int rpa0, jka0, rpa1, jka1, rpc0, jkc0, rpc1, jkc1;
            attn_gen(grpA, gblkA, rA, maxbA, j0A, rpa0, jka0); attn_load(a0, KbhA, VbhA, rpa0, jka0, qi, g);
            attn_gen(grpA, gblkA, rA, maxbA, j0A, rpa1, jka1); attn_load(a1, KbhA, VbhA, rpa1, jka1, qi, g);
            attn_gen(grpB, gblkB, rB, maxbB, j0B, rpc0, jkc0); attn_load(c0, KbhB, VbhB, rpc0, jkc0, qi, g);
            attn_gen(grpB, gblkB, rB, maxbB, j0B, rpc1, jkc1); attn_load(c1, KbhB, VbhB, rpc1, jkc1, qi, g);
            attn_compute2(a0, rpa0, jka0, a1, rpa1, jka1, rA, jqA, g, qf0A, qf1A, oA, mrunA, lrunA, t < TA, t + 1 < TA);
            attn_compute2(c0, rpc0, jkc0, c1, rpc1, jkc1, rB, jqB, g, qf0B, qf1B, oB, mrunB, lrunB, t < TB, t + 1 < TB);
        }
        ATTN_UNIT_STORE(A); ATTN_UNIT_STORE(B);
    }
}
#define ATTN_PAIR_SETUP(X, jb_) \
        const int bh##X = bhp, r##X = rp_, jb##X = (jb_), j0##X = 16 * jb##X, b##X = bh##X >> 2, hd##X = bh##X & 3; \
        const bf16_t* qp##X = Q16 + ((size_t)bh##X * 16 + r##X) * 256 * 64 + (size_t)jb##X * 1024 + qi * 32 + 8 * g; \
        const bf16x8 qf0##X = *(const bf16x8*)qp##X, qf1##X = *(const bf16x8*)(qp##X + 512); \
        const bf16_t* Kbh##X = K16 + (size_t)bh##X * 16 * 256 * 64; const bf16_t* Vbh##X = VT16 + (size_t)bh##X * 16 * 64 * 256; \
        f32x4 o##X[4]; _Pragma("unroll") for (int dg = 0; dg < 4; ++dg) o##X[dg] = (f32x4){0.f, 0.f, 0.f, 0.f}; \
        float mrun##X = NEGF, lrun##X = 0.f; \
        const int jq##X = j0##X + qi, maxb##X = (j0##X + 47) >> 5; \
        const int T##X = attn_nb(r##X, r##X, maxb##X) + 3 * attn_nb((r##X + 4) & 15, r##X, maxb##X) + 12; \
        int grp##X = 0, gblk##X = -1;
DEV void phase_attn_adj(Ctx& C) {
    PHASE_LOCALS
    const bf16_t* Q16 = (const bf16_t*)(ws + WS_Q16); const bf16_t* K16 = (const bf16_t*)(ws + WS_K16); const bf16_t* VT16 = (const bf16_t*)(ws + WS_VT16);
    bf16_t* MIX = (bf16_t*)(ws + WS_U);
    const int qi = lane & 15, g = lane >> 4;
    for (int kit = 0, u0 = gw; u0 < NBH * 128; ++kit, u0 += ngw) {
        const int up = xcd_deal(gw, kit, ngw, NBH * 128), bhp = up >> 7, rp_ = (up >> 3) & 15, jp = ((up & 7) + 3 * kit) & 7;
        ATTN_PAIR_SETUP(A, 2 * jp)
        ATTN_PAIR_SETUP(B, 2 * jp + 1)
        const int Tm = TA > TB ? TA : TB;
        for (int t = 0; t < Tm; t += 2) {
            AttnBlk a0, a1, c0, c1; int rpa0, jka0, rpa1, jka1, rpc0, jkc0, rpc1, jkc1;
            attn_gen(grpA, gblkA, rA, maxbA, j0A, rpa0, jka0); attn_load(a0, KbhA, VbhA, rpa0, jka0, qi, g);
            attn_gen(grpA, gblkA, rA, maxbA, j0A, rpa1, jka1); attn_load(a1, KbhA, VbhA, rpa1, jka1, qi, g);
            attn_gen(grpB, gblkB, rB, maxbB, j0B, rpc0, jkc0); attn_load(c0, KbhB, VbhB, rpc0, jkc0, qi, g);
            attn_gen(grpB, gblkB, rB, maxbB, j0B, rpc1, jkc1); attn_load(c1, KbhB, VbhB, rpc1, jkc1, qi, g);
            attn_compute2(a0, rpa0, jka0, a1, rpa1, jka1, rA, jqA, g, qf0A, qf1A, oA, mrunA, lrunA, t < TA, t + 1 < TA);
            attn_compute2(c0, rpc0, jkc0, c1, rpc1, jkc1, rB, jqB, g, qf0B, qf1B, oB, mrunB, lrunB, t < TB, t + 1 < TB);
        }
        ATTN_UNIT_STORE(A); ATTN_UNIT_STORE(B);
    }
}
#undef ATTN_PAIR_SETUP
#undef ATTN_UNIT_SETUP
#undef ATTN_UNIT_STORE
DEV void phase_attn_single(Ctx& C) {
    PHASE_LOCALS
    const bf16_t* Q16 = (const bf16_t*)(ws + WS_Q16); const bf16_t* K16 = (const bf16_t*)(ws + WS_K16); const bf16_t* VT16 = (const bf16_t*)(ws + WS_VT16);
    bf16_t* MIX = (bf16_t*)(ws + WS_U);
    const int qi = lane & 15, g = lane >> 4;
    const bool xdeal = ((ngw & 7) == 0) && ((NBH * 256) % ngw == 0);
    for (int kit = 0, u0 = gw; u0 < NBH * 256; ++kit, u0 += ngw) {
        const int u = xdeal ? xcd_deal(gw, kit, ngw, NBH * 256) : u0;
        const int bh = u >> 8, r = (u >> 4) & 15, jb = ((u & 15) + 5 * kit) & 15, j0 = 16 * jb, b = bh >> 2, hd = bh & 3;
        const bf16_t* qp = Q16 + ((size_t)bh * 16 + r) * 256 * 64 + (size_t)jb * 1024 + qi * 32 + 8 * g;
        const bf16x8 qf0 = *(const bf16x8*)qp, qf1 = *(const bf16x8*)(qp + 512);
        const bf16_t* Kbh = K16 + (size_t)bh * 16 * 256 * 64; const bf16_t* Vbh = VT16 + (size_t)bh * 16 * 64 * 256;
        f32x4 o[4];
#pragma unroll
        for (int dg = 0; dg < 4; ++dg) o[dg] = (f32x4){0.f, 0.f, 0.f, 0.f};
        float mrun = NEGF, lrun = 0.f;
        const int jq = j0 + qi, maxb = (j0 + 47) >> 5;
        const int T = attn_nb(r, r, maxb) + 3 * attn_nb((r + 4) & 15, r, maxb) + 12;
        int grp = 0, gblk = -1;
        for (int t = 0; t < T; t += 4) {
            AttnBlk b0, b1, b2, b3; int rp0, jk0, rp1, jk1, rp2, jk2, rp3, jk3;
            ATTN_GEN(rp0, jk0); attn_load(b0, Kbh, Vbh, rp0, jk0, qi, g);
            ATTN_GEN(rp1, jk1); attn_load(b1, Kbh, Vbh, rp1, jk1, qi, g);
            ATTN_GEN(rp2, jk2); attn_load(b2, Kbh, Vbh, rp2, jk2, qi, g);
            ATTN_GEN(rp3, jk3); attn_load(b3, Kbh, Vbh, rp3, jk3, qi, g);
#if MK_ATTN_FLAT
            attn_compute2(b0, rp0, jk0, b1, rp1, jk1, r, jq, g, qf0, qf1, o, mrun, lrun, true, t + 1 < T);
            attn_compute2(b2, rp2, jk2, b3, rp3, jk3, r, jq, g, qf0, qf1, o, mrun, lrun, t + 2 < T, t + 3 < T);
#else
            if (t + 1 < T) attn_compute2(b0, rp0, jk0, b1, rp1, jk1, r, jq, g, qf0, qf1, o, mrun, lrun); else attn_compute(b0, rp0, jk0, r, jq, g, qf0, qf1, o, mrun, lrun);
            if (t + 3 < T) attn_compute2(b2, rp2, jk2, b3, rp3, jk3, r, jq, g, qf0, qf1, o, mrun, lrun); else if (t + 2 < T) attn_compute(b2, rp2, jk2, r, jq, g, qf0, qf1, o, mrun, lrun);
#endif
        }
        const float linv = fast_rcp(quad_sum(lrun));
        const int s = 16 * jq + r; bf16_t* op = MIX + ((size_t)b * SEQ + s) * 1024 + 64 * hd + 4 * g;
#pragma unroll
        for (int dg = 0; dg < 4; ++dg) { const f32x4 v = o[dg] * linv; u32x2 w; w.x = pk2(v[0], v[1]); w.y = pk2(v[2], v[3]); *(u32x2*)(op + 16 * dg) = w; }
    }
}

struct AttnTile { bf16x8 k[2]; u32x2 v[4]; };
DEV void attn_load_tile(AttnTile& T, const bf16_t* kc, const bf16_t* vc, int jt, int qi, int g) {
    int jr = 16 * jt + qi; jr = jr < 0 ? 0 : jr; const bf16_t* kp = kc + (size_t)(jr >> 4) * 1024 + (jr & 15) * 32 + 8 * g;
    T.k[0] = *(const bf16x8*)kp; T.k[1] = *(const bf16x8*)(kp + 512);
    const int jc = jt < 0 ? 0 : jt; const bf16_t* vp = vc + (size_t)jc * 1024 + qi * 16 + 4 * g;
#pragma unroll
    for (int dg = 0; dg < 4; ++dg) T.v[dg] = *(const u32x2*)(vp + dg * 256);
}
DEV void attn_mkblk(AttnBlk& B, const AttnTile& a, const AttnTile& b) { B.k[0] = a.k[0]; B.k[1] = a.k[1]; B.k[2] = b.k[0]; B.k[3] = b.k[1];
#pragma unroll
    for (int dg = 0; dg < 4; ++dg) { B.v[2 * dg] = a.v[dg]; B.v[2 * dg + 1] = b.v[dg]; } }
DEV void phase_attn_pair(Ctx& C) {
    PHASE_LOCALS
    const bf16_t* Q16 = (const bf16_t*)(ws + WS_Q16); const bf16_t* K16 = (const bf16_t*)(ws + WS_K16); const bf16_t* VT16 = (const bf16_t*)(ws + WS_VT16);
    bf16_t* MIX = (bf16_t*)(ws + WS_U);
    const int qi = lane & 15, g = lane >> 4;
    for (int kit = 0, u0 = gw; u0 < NBH * 128; ++kit, u0 += ngw) {
        const int up = xcd_deal(gw, kit, ngw, NBH * 128), bh = up >> 7, r = (up >> 3) & 15, jp = ((up & 7) + 3 * kit) & 7, b = bh >> 2, hd = bh & 3;
        const int j0 = 32 * jp, jqA = j0 + qi, jqB = j0 + 16 + qi, maxb = (j0 + 47) >> 5;
        const bf16_t* qp = Q16 + ((size_t)bh * 16 + r) * 256 * 64 + (size_t)(2 * jp) * 1024 + qi * 32 + 8 * g;
        const bf16x8 qA0 = *(const bf16x8*)qp, qA1 = *(const bf16x8*)(qp + 512), qB0 = *(const bf16x8*)(qp + 1024), qB1 = *(const bf16x8*)(qp + 1536);
        const bf16_t* Kbh = K16 + (size_t)bh * 16 * 256 * 64; const bf16_t* Vbh = VT16 + (size_t)bh * 16 * 64 * 256;
        f32x4 oA[4], oB[4];
#pragma unroll
        for (int dg = 0; dg < 4; ++dg) { oA[dg] = (f32x4){0.f, 0.f, 0.f, 0.f}; oB[dg] = (f32x4){0.f, 0.f, 0.f, 0.f}; }
        float mA = NEGF, lA = 0.f, mB = NEGF, lB = 0.f;
        const int T = attn_nb(r, r, maxb) + 3 * attn_nb((r + 4) & 15, r, maxb) + 12;
        int grp = 0, gblk = -1;
        for (int t = 0; t < T; t += 2) {
            int rp0, jk0, rp1, jk1; AttnTile t00, t01, t02, t10, t11, t12;
            attn_gen(grp, gblk, r, maxb, j0, rp0, jk0);
            { const bf16_t* kc = Kbh + (size_t)rp0 * 256 * 64; const bf16_t* vc = Vbh + (size_t)rp0 * 64 * 256; const int jt = jk0 >> 4;
              attn_load_tile(t00, kc, vc, jt, qi, g); attn_load_tile(t01, kc, vc, jt + 1, qi, g); attn_load_tile(t02, kc, vc, jt + 2, qi, g); }
            attn_gen(grp, gblk, r, maxb, j0, rp1, jk1);
            { const bf16_t* kc = Kbh + (size_t)rp1 * 256 * 64; const bf16_t* vc = Vbh + (size_t)rp1 * 64 * 256; const int jt = jk1 >> 4;
              attn_load_tile(t10, kc, vc, jt, qi, g); attn_load_tile(t11, kc, vc, jt + 1, qi, g); attn_load_tile(t12, kc, vc, jt + 2, qi, g); }
            AttnBlk a0, a1, c0, c1; attn_mkblk(a0, t00, t01); attn_mkblk(a1, t10, t11); attn_mkblk(c0, t01, t02); attn_mkblk(c1, t11, t12);
            const bool l1 = t + 1 < T;
            attn_compute2(a0, rp0, jk0, a1, rp1, jk1, r, jqA, g, qA0, qA1, oA, mA, lA, true, l1);
            attn_compute2(c0, rp0, jk0 + 16, c1, rp1, jk1 + 16, r, jqB, g, qB0, qB1, oB, mB, lB, true, l1);
        }
        { const float linv = fast_rcp(quad_sum(lA)); bf16_t* op = MIX + ((size_t)b * SEQ + 16 * jqA + r) * 1024 + 64 * hd + 4 * g;
#pragma unroll
          for (int dg = 0; dg < 4; ++dg) { const f32x4 v = oA[dg] * linv; u32x2 w; w.x = pk2(v[0], v[1]); w.y = pk2(v[2], v[3]); *(u32x2*)(op + 16 * dg) = w; } }
        { const float linv = fast_rcp(quad_sum(lB)); bf16_t* op = MIX + ((size_t)b * SEQ + 16 * jqB + r) * 1024 + 64 * hd + 4 * g;
#pragma unroll
          for (int dg = 0; dg < 4; ++dg) { const f32x4 v = oB[dg] * linv; u32x2 w; w.x = pk2(v[0], v[1]); w.y = pk2(v[2], v[3]); *(u32x2*)(op + 16 * dg) = w; } }
    }
}
DEV void phase_attn(Ctx& C) { const int ngw_ = C.nblk * 8; if (MK_ATTN_DUAL == 3 && (ngw_ & 7) == 0 && ((NBH * 128) % ngw_) == 0) phase_attn_pair(C); else if (MK_ATTN_DUAL == 2 && (ngw_ & 7) == 0 && ((NBH * 128) % ngw_) == 0) phase_attn_adj(C); else if (MK_ATTN_DUAL == 1 && ((NBH * 256) % (2 * ngw_)) == 0) phase_attn_dual(C); else phase_attn_single(C); }

DEV void phase_pool(Ctx& C, int l) {
    PHASE_LOCALS
    const bf16_t* PIN = (const bf16_t*)(ws + WS_PIN); const bf16_t* pwt = (const bf16_t*)(ws + WS_PWT) + (size_t)l * 4 * 64 * 64;
    const float* psc = (const float*)(ws + SM_POOLS) + l * 256; bf16_t* MIX = (bf16_t*)(ws + WS_U);
    const int ri = lane & 15, q = lane >> 4;
    for (int u = gw; u < M / 16; u += ngw) {
        const int row = 16 * u + ri, s = row & (SEQ - 1);
#pragma unroll
        for (int g = 0; g < 4; ++g) {
            const int w = 2 << g, cnt = (s + 1) < w ? (s + 1) : w; const float inv = 1.0f / (float)cnt;
            bf16x8 df[2];
#pragma unroll
            for (int ks = 0; ks < 2; ++ks) { const bf16_t* pp = PIN + (size_t)row * 256 + 64 * g + 32 * ks + 8 * q;
                float sum[8];
#pragma unroll
                for (int e = 0; e < 8; ++e) sum[e] = 0.f;
                u32x4 vw[16];
                SCHED_FENCE();
#pragma unroll
                for (int k = 0; k < (2 << g); ++k) { const unsigned vo = (unsigned)(((row - (k <= s ? k : 0)) * 256 + 64 * g + 32 * ks + 8 * q) * 2); vw[k] = *(const u32x4*)((const char*)PIN + vo); }
                SCHED_FENCE();
                const u32x4 cur = vw[0];
#pragma unroll
                for (int k = 0; k < (2 << g); ++k) { const unsigned mk = k <= s ? 0xffffffffu : 0u; const u32x4 v = (u32x4){vw[k].x & mk, vw[k].y & mk, vw[k].z & mk, vw[k].w & mk};
                    sum[0] += bflo(v.x); sum[1] += bfhi(v.x); sum[2] += bflo(v.y); sum[3] += bfhi(v.y); sum[4] += bflo(v.z); sum[5] += bfhi(v.z); sum[6] += bflo(v.w); sum[7] += bfhi(v.w); }
                df[ks] = mk8(pk2(sum[0] * inv - bflo(cur.x), sum[1] * inv - bfhi(cur.x)), pk2(sum[2] * inv - bflo(cur.y), sum[3] * inv - bfhi(cur.y)),
                             pk2(sum[4] * inv - bflo(cur.z), sum[5] * inv - bfhi(cur.z)), pk2(sum[6] * inv - bflo(cur.w), sum[7] * inv - bfhi(cur.w))); }
#pragma unroll
            for (int eb = 0; eb < 4; ++eb) { SCHED_FENCE(); const bf16_t* wp = pwt + ((size_t)g * 64 + 16 * eb + ri) * 64 + 8 * q;
                f32x4 acc = mfma16(*(const bf16x8*)wp, df[0], (f32x4){0.f, 0.f, 0.f, 0.f}); acc = mfma16(*(const bf16x8*)(wp + 32), df[1], acc);
                const f32x4 sc = *(const f32x4*)(psc + 64 * g + 16 * eb + 4 * q); acc = acc * sc;
                u32x2 wv; wv.x = pk2(acc[0], acc[1]); wv.y = pk2(acc[2], acc[3]);
                *(u32x2*)(MIX + (size_t)row * 1024 + 256 + 64 * g + 16 * eb + 4 * q) = wv; }
        }
    }
}

constexpr int XC_STR = 136, KT_STR = 72;
constexpr int LA_XC = 0, LA_XM = 64 * XC_STR * 2, LA_KT = 2 * 64 * XC_STR * 2, LA_VT = LA_KT + 128 * KT_STR * 2, LA_WA = LA_VT + 128 * KT_STR * 2;
#define MA_PREFETCH(uu) do { const int bh_ = (uu) >> 6, c_ = (uu) & 63, b_ = bh_ >> 2, hd_ = bh_ & 3; \
        _Pragma("unroll") for (int t = 0; t < 4; ++t) { int sp_ = 64 * c_ + (tid >> 3) - 3 + t; sp_ = sp_ < 0 ? 0 : sp_; \
            const bf16_t* xp_ = XM + ((size_t)b_ * SEQ + sp_) * 512 + 128 * hd_ + (tid & 7) * 16; pre[2 * t] = *(const u32x4*)xp_; pre[2 * t + 1] = *(const u32x4*)(xp_ + 8); } \
        pgf = GF[(size_t)hd_ * M + (size_t)b_ * SEQ + 64 * c_ + lane]; pgi = GI[(size_t)hd_ * M + (size_t)b_ * SEQ + 64 * c_ + lane]; } while (0)
DEV void phase_mlstm_a(Ctx& C, int l) {
    PHASE_LOCALS
    const bf16_t* XM = (const bf16_t*)(ws + WS_XM); bf16_t* XC = (bf16_t*)(ws + WS_XC);
    bf16_t* MQ = (bf16_t*)(ws + WS_MQ); bf16_t* MK = (bf16_t*)(ws + WS_MK); bf16_t* MVT = (bf16_t*)(ws + WS_MVT);
    bf16_t* DCT = (bf16_t*)(ws + WS_DCT); float* DN = (float*)(ws + WS_DN);
    const float* GI = (const float*)(ws + WS_GI); const float* GF = (const float*)(ws + WS_GF);
    float* BCUM = (float*)(ws + WS_BCUM); float* BL = (float*)(ws + WS_BL); float* AM = (float*)(ws + WS_AM);
    const bf16_t* wqt = (const bf16_t*)(ws + WS_WQT) + (size_t)l * 3 * 4 * 128 * 128;
    const float* cw = (const float*)(ws + SM_CONVW) + l * 4 * 512; const float* cb = (const float*)(ws + SM_CONVB) + l * 512;
    LAS bf16_t* xcL = (LAS bf16_t*)(C.lds + LA_XC); LAS bf16_t* xmL = (LAS bf16_t*)(C.lds + LA_XM); LAS bf16_t* kT = (LAS bf16_t*)(C.lds + LA_KT); LAS bf16_t* vT = (LAS bf16_t*)(C.lds + LA_VT); LAS float* waL = (LAS float*)(C.lds + LA_WA);
    const int w = wave, ri = lane & 15, g = lane >> 4;
    const int NU = NBH * NCH;
    u32x4 pre[8]; float pgf, pgi; bf16x8 wf[3][4]; int hd_prev = -1;
    const bool xdeal = (NU % C.nblk) == 0; const int KU = NU / C.nblk;
    if (C.blk < NU) MA_PREFETCH(xdeal ? vblk * KU : C.blk);
    for (int kit = 0, u0 = C.blk; u0 < NU; ++kit, u0 += C.nblk) {
        const int u = xdeal ? vblk * KU + kit : u0;
        const int bh = u >> 6, c = u & 63, b = bh >> 2, hd = bh & 3, s0 = 64 * c; const size_t row0 = (size_t)b * SEQ + s0;
        { const int lr = tid >> 3, ch = 128 * hd + (tid & 7) * 16;
          float a[16];
#pragma unroll
          for (int e = 0; e < 16; ++e) a[e] = cb[ch + e];
#pragma unroll
          for (int t = 0; t < 4; ++t) { const float on = (s0 + lr - 3 + t) >= 0 ? 1.0f : 0.0f; const float* wp = cw + t * 512 + ch;
              const unsigned vv[8] = {pre[2 * t].x, pre[2 * t].y, pre[2 * t].z, pre[2 * t].w, pre[2 * t + 1].x, pre[2 * t + 1].y, pre[2 * t + 1].z, pre[2 * t + 1].w};
#pragma unroll
              for (int e = 0; e < 8; ++e) { a[2 * e] += on * wp[2 * e] * bflo(vv[e]); a[2 * e + 1] += on * wp[2 * e + 1] * bfhi(vv[e]); } }
          unsigned pw[8];
#pragma unroll
          for (int e = 0; e < 8; ++e) pw[e] = pk2(a[2 * e] * sigmoid_f(a[2 * e]), a[2 * e + 1] * sigmoid_f(a[2 * e + 1]));
          u32x4 o0, o1; o0.x = pw[0]; o0.y = pw[1]; o0.z = pw[2]; o0.w = pw[3]; o1.x = pw[4]; o1.y = pw[5]; o1.z = pw[6]; o1.w = pw[7];
          *(LAS u32x4*)(xcL + lr * XC_STR + (tid & 7) * 16) = o0; *(LAS u32x4*)(xcL + lr * XC_STR + (tid & 7) * 16 + 8) = o1;
          *(LAS u32x4*)(xmL + lr * XC_STR + (tid & 7) * 16) = pre[6]; *(LAS u32x4*)(xmL + lr * XC_STR + (tid & 7) * 16 + 8) = pre[7];
          bf16_t* gp = XC + (row0 + lr) * 512 + ch; *(u32x4*)gp = o0; *(u32x4*)(gp + 8) = o1; }
        if (w == 0) {
            const float f = pgf, ip = pgi;
            const float lf = fminf(f, 0.f) - __logf(1.0f + __expf(-fabsf(f)));
            const float bc = wave_prefix_sum(lf);
            const float blast = lane63(bc), a = blast - bc + ip;
            const float amax = wave_max(a);
            waL[lane] = __expf(a - amax); BCUM[(size_t)hd * M + row0 + lane] = bc;
            if (lane == 0) { BL[u] = blast; AM[u] = amax; }
        }
        if (hd != hd_prev) {
#pragma unroll
            for (int which = 0; which < 3; ++which) { const bf16_t* wp = wqt + (((size_t)which * 4 + hd) * 128 + 16 * w + ri) * 128 + 8 * g;
#pragma unroll
                for (int ks = 0; ks < 4; ++ks) wf[which][ks] = *(const bf16x8*)(wp + 32 * ks); }
            hd_prev = hd; }
        __syncthreads();
        { const int un = xdeal ? (kit + 1 < KU ? u + 1 : u) : (u + C.nblk < NU ? u + C.nblk : u); MA_PREFETCH(un); }
#pragma unroll
        for (int which = 0; which < 3; ++which) {
#pragma unroll
            for (int rb = 0; rb < 4; ++rb) {
                bf16x8 xf[4];
#pragma unroll
                for (int ks = 0; ks < 4; ++ks) xf[ks] = *(const LAS bf16x8*)((which == 2 ? xmL : xcL) + (16 * rb + ri) * XC_STR + 32 * ks + 8 * g);
                if (which <= 1) {
                    f32x4 at = (f32x4){0.f, 0.f, 0.f, 0.f};
#pragma unroll
                    for (int ks = 0; ks < 4; ++ks) at = mfma16(wf[which][ks], xf[ks], at);
                    if (which == 0) at = at * 0.08838834764831845f;
                    u32x2 o; o.x = pk2(at[0], at[1]); o.y = pk2(at[2], at[3]);
                    *(u32x2*)((which == 0 ? MQ : MK) + (((size_t)u * 4 + rb) * 4 + (w >> 1)) * 512 + ri * 32 + (2 * (w & 1) + (g >> 1)) * 8 + 4 * (g & 1)) = o; }
                if (which >= 1) {
                    f32x4 an = (f32x4){0.f, 0.f, 0.f, 0.f};
#pragma unroll
                    for (int ks = 0; ks < 4; ++ks) an = mfma16(xf[ks], wf[which][ks], an);
                    if (which == 1) { an = an * *(const LAS f32x4*)(waL + 16 * rb + 4 * g); }
                    u32x2 o; o.x = pk2(an[0], an[1]); o.y = pk2(an[2], an[3]);
                    *(LAS u32x2*)((which == 1 ? kT : vT) + (16 * w + ri) * KT_STR + 16 * rb + 4 * g) = o;
                    if (which == 2) *(u32x2*)(MVT + (((size_t)u * 8 + w) * 2 + (rb >> 1)) * 512 + ri * 32 + g * 8 + (rb & 1) * 4) = o; }
            }
        }
        __syncthreads();
        { bf16x8 af[2];
#pragma unroll
          for (int ls = 0; ls < 2; ++ls) af[ls] = *(const LAS bf16x8*)(kT + (16 * w + ri) * KT_STR + 32 * ls + 8 * g);
          float dn = 0.f;
#pragma unroll
          for (int ls = 0; ls < 2; ++ls) { const u32x4 t = __builtin_bit_cast(u32x4, af[ls]); dn += (bflo(t.x) + bfhi(t.x)) + (bflo(t.y) + bfhi(t.y)) + (bflo(t.z) + bfhi(t.z)) + (bflo(t.w) + bfhi(t.w)); }
          dn = quad_sum(dn);
          if (g == 0) DN[(size_t)u * 128 + 16 * w + ri] = dn;
#pragma unroll
          for (int eb = 0; eb < 8; ++eb) { f32x4 acc = (f32x4){0.f, 0.f, 0.f, 0.f};
#pragma unroll
              for (int ls = 0; ls < 2; ++ls) acc = mfma16(af[ls], *(const LAS bf16x8*)(vT + (16 * eb + ri) * KT_STR + 32 * ls + 8 * g), acc);
              { u32x2 ov; ov.x = pk2(acc[0], acc[1]); ov.y = pk2(acc[2], acc[3]); *(u32x2*)(DCT + (((size_t)u * 8 + eb) * 4 + (w >> 1)) * 512 + ri * 32 + (2 * (w & 1) + (g >> 1)) * 8 + 4 * (g & 1)) = ov; } } }
        __syncthreads();
    }
}
#undef MA_PREFETCH

DEV void phase_scan(Ctx& C) {
    PHASE_LOCALS
    bf16_t* DCT = (bf16_t*)(ws + WS_DCT); float* DN = (float*)(ws + WS_DN);
    const float* BL = (const float*)(ws + WS_BL); const float* AM = (const float*)(ws + WS_AM); float* MP = (float*)(ws + WS_MP);
    constexpr int GRP = 16;
    for (int it = vblk * 512 + tid; it < NBH * 4096; it += C.nblk * 512) {
        const int bh = it >> 12, rem = it & 4095, e = ((rem >> 9) << 4) + ((rem >> 3) & 15), d = (((rem >> 7) & 3) << 5) + (((rem >> 1) & 3) << 3) + ((rem & 1) << 2);
        f32x4 Cs = (f32x4){0.f, 0.f, 0.f, 0.f}, Ns = (f32x4){0.f, 0.f, 0.f, 0.f}; float m = 0.f;
        for (int c0 = 0; c0 < NCH; c0 += GRP) {
            u32x2 dw[GRP]; f32x4 dnv[GRP]; float bl[GRP], am[GRP];
#pragma unroll
            for (int k = 0; k < GRP; ++k) { const int u = bh * NCH + c0 + k; dw[k] = *(const u32x2*)(DCT + (size_t)u * 16384 + rem * 4); bl[k] = BL[u]; am[k] = AM[u];
                dnv[k] = e == 0 ? *(const f32x4*)(DN + (size_t)u * 128 + d) : (f32x4){0.f, 0.f, 0.f, 0.f}; }
#pragma unroll
            for (int k = 0; k < GRP; ++k) { const int u = bh * NCH + c0 + k;
                const float mn = fmaxf(bl[k] + m, am[k]), decay = __expf(bl[k] + m - mn), inj = __expf(am[k] - mn);
                const f32x4 dc = (f32x4){bflo(dw[k].x), bfhi(dw[k].x), bflo(dw[k].y), bfhi(dw[k].y)};
                { u32x2 cw2; cw2.x = pk2(Cs[0], Cs[1]); cw2.y = pk2(Cs[2], Cs[3]); *(u32x2*)(DCT + (size_t)u * 16384 + rem * 4) = cw2; } Cs = Cs * decay + dc * inj;
                if (e == 0) { *(f32x4*)(DN + (size_t)u * 128 + d) = Ns; Ns = Ns * decay + dnv[k] * inj; }
                if (rem == 0) MP[u] = m;
                m = mn; }
        }
    }
}

DEV void phase_mlstm_c(Ctx& C, int l) {
    PHASE_LOCALS
    const bf16_t* MQ = (const bf16_t*)(ws + WS_MQ); const bf16_t* MK = (const bf16_t*)(ws + WS_MK); const bf16_t* MVT = (const bf16_t*)(ws + WS_MVT);
    const bf16_t* OG = (const bf16_t*)(ws + WS_OG); const bf16_t* XC = (const bf16_t*)(ws + WS_XC); bf16_t* MIX = (bf16_t*)(ws + WS_U);
    const bf16_t* CPT = (const bf16_t*)(ws + WS_DCT); const float* NP = (const float*)(ws + WS_DN);
    const float* GI = (const float*)(ws + WS_GI); const float* BCUM = (const float*)(ws + WS_BCUM); const float* MP = (const float*)(ws + WS_MP);
    const float* nw = (const float*)(ws + SM_NORMW) + l * 512; const float* sk = (const float*)(ws + SM_SKIP) + l * 512;
    const int ri = lane & 15, g = lane >> 4;
    const bool xdeal = ((ngw & 7) == 0) && ((NBH * NCH * 4) % ngw == 0);
    for (int kit = 0, w0 = gw; w0 < NBH * NCH * 4; ++kit, w0 += ngw) {
        const int wu = xdeal ? xcd_deal(gw, kit, ngw, NBH * NCH * 4) : w0;
        const int u = wu >> 2, lb = wu & 3, bh = u >> 6, c = u & 63, b = bh >> 2, hd = bh & 3; const size_t row0 = (size_t)b * SEQ + 64 * c;
        const int lrow = 16 * lb + ri; const size_t grow = row0 + lrow;
        const float bl_l = BCUM[(size_t)hd * M + grow], mprev = MP[u];
        f32x4 bs[4], is[4]; bf16x8 qf[4], kf[4][4]; f32x4 n0[4], n1[4];
#pragma unroll
        for (int sb = 0; sb < 4; ++sb) { bs[sb] = *(const f32x4*)(BCUM + (size_t)hd * M + row0 + 16 * sb + 4 * g); is[sb] = *(const f32x4*)(GI + (size_t)hd * M + row0 + 16 * sb + 4 * g); }
#pragma unroll
        for (int ks = 0; ks < 4; ++ks) { qf[ks] = *(const bf16x8*)(MQ + (((size_t)u * 4 + lb) * 4 + ks) * 512 + ri * 32 + g * 8);
            n0[ks] = *(const f32x4*)(NP + (size_t)u * 128 + 32 * ks + 8 * g); n1[ks] = *(const f32x4*)(NP + (size_t)u * 128 + 32 * ks + 8 * g + 4); }
#pragma unroll
        for (int sb = 0; sb < 4; ++sb)
#pragma unroll
            for (int ks = 0; ks < 4; ++ks) kf[sb][ks] = *(const bf16x8*)(MK + (((size_t)u * 4 + sb) * 4 + ks) * 512 + ri * 32 + g * 8);
        SCHED_FENCE();
        float ld[4][4]; float mx = NEGF;
#pragma unroll
        for (int sb = 0; sb < 4; ++sb)
#pragma unroll
            for (int i = 0; i < 4; ++i) { ld[sb][i] = (16 * sb + 4 * g + i <= lrow) ? bl_l - bs[sb][i] + is[sb][i] : NEGF; mx = fmaxf(mx, ld[sb][i]); }
        mx = quad_max(mx);
        const float mt = fmaxf(bl_l + mprev, mx), iw = __expf(bl_l + mprev - mt);
        float sw[4][4]; float dsum = 0.f;
#pragma unroll
        for (int sb = 0; sb < 4; ++sb) { f32x4 st = (f32x4){0.f, 0.f, 0.f, 0.f};
#pragma unroll
            for (int ks = 0; ks < 4; ++ks) st = mfma16(kf[sb][ks], qf[ks], st);
#pragma unroll
            for (int i = 0; i < 4; ++i) { sw[sb][i] = st[i] * __expf(ld[sb][i] - mt); dsum += sw[sb][i]; } }
        float dq = 0.f; bf16x8 qs[4];
#pragma unroll
        for (int ks = 0; ks < 4; ++ks) { const u32x4 t = __builtin_bit_cast(u32x4, qf[ks]);
            const f32x4 q0 = (f32x4){bflo(t.x), bfhi(t.x), bflo(t.y), bfhi(t.y)}, q1 = (f32x4){bflo(t.z), bfhi(t.z), bflo(t.w), bfhi(t.w)};
            dq += (q0[0] * n0[ks][0] + q0[1] * n0[ks][1]) + (q0[2] * n0[ks][2] + q0[3] * n0[ks][3]) + (q1[0] * n1[ks][0] + q1[1] * n1[ks][1]) + (q1[2] * n1[ks][2] + q1[3] * n1[ks][3]);
            qs[ks] = pack8(q0 * iw, q1 * iw); }
        dq = quad_sum(dq); dsum = quad_sum(dsum);
        const float den = iw * dq + dsum, hs = fast_rcp(fmaxf(fabsf(den), __expf(-mt)));
        const bf16x8 pf0 = mk8(pk2(sw[0][0], sw[0][1]), pk2(sw[0][2], sw[0][3]), pk2(sw[1][0], sw[1][1]), pk2(sw[1][2], sw[1][3]));
        const bf16x8 pf1 = mk8(pk2(sw[2][0], sw[2][1]), pk2(sw[2][2], sw[2][3]), pk2(sw[3][0], sw[3][1]), pk2(sw[3][2], sw[3][3]));
        f32x4 hv[8]; u32x2 xcw[8]; float ss = 0.f;
#pragma unroll
        for (int hf = 0; hf < 4; ++hf) {
            bf16x8 cf[2][4], vf[2][2]; u32x2 ogw[2];
#pragma unroll
            for (int e4 = 0; e4 < 2; ++e4) { const int eb = 2 * hf + e4;
                const bf16_t* cp = CPT + ((size_t)u * 8 + eb) * 2048 + ri * 32 + g * 8; const bf16_t* vp = MVT + ((size_t)u * 8 + eb) * 1024 + ri * 32 + g * 8;
#pragma unroll
                for (int ks = 0; ks < 4; ++ks) cf[e4][ks] = *(const bf16x8*)(cp + 512 * ks);
                vf[e4][0] = *(const bf16x8*)vp; vf[e4][1] = *(const bf16x8*)(vp + 512);
                ogw[e4] = *(const u32x2*)(OG + grow * 512 + 128 * hd + 16 * eb + 4 * g); xcw[eb] = *(const u32x2*)(XC + grow * 512 + 128 * hd + 16 * eb + 4 * g); }
            SCHED_FENCE();
#pragma unroll
            for (int e4 = 0; e4 < 2; ++e4) { const int eb = 2 * hf + e4; f32x4 acc = (f32x4){0.f, 0.f, 0.f, 0.f};
#pragma unroll
                for (int ks = 0; ks < 4; ++ks) acc = mfma16(cf[e4][ks], qs[ks], acc);
                acc = mfma16(vf[e4][0], pf0, acc); acc = mfma16(vf[e4][1], pf1, acc);
                acc = acc * hs; acc[0] *= sigmoid_f(bflo(ogw[e4].x)); acc[1] *= sigmoid_f(bfhi(ogw[e4].x)); acc[2] *= sigmoid_f(bflo(ogw[e4].y)); acc[3] *= sigmoid_f(bfhi(ogw[e4].y));
                hv[eb] = acc; ss += (acc[0] * acc[0] + acc[1] * acc[1]) + (acc[2] * acc[2] + acc[3] * acc[3]); }
        }
        const float rstd = rsqrtf(quad_sum(ss) * (1.0f / 128.0f) + EPS);
#pragma unroll
        for (int eb = 0; eb < 8; ++eb) { const int col = 128 * hd + 16 * eb + 4 * g;
            const f32x4 nv = *(const f32x4*)(nw + col), sv = *(const f32x4*)(sk + col);
            const f32x4 xcv = (f32x4){bflo(xcw[eb].x), bfhi(xcw[eb].x), bflo(xcw[eb].y), bfhi(xcw[eb].y)};
            f32x4 o = hv[eb] * rstd * nv + sv * xcv;
            u32x2 wv; wv.x = pk2(o[0], o[1]); wv.y = pk2(o[2], o[3]); *(u32x2*)(MIX + grow * 1024 + 512 + col) = wv; }
    }
}
#ifndef EMU
constexpr int LDS_BYTES = 147456, MISC_OFF = 131072 + 320, CW_BAR = 4096;
constexpr int N_PHASES = 2 + 4 * 12;
#ifndef PHM
#define PHM 0xffff
#endif
#ifndef PG8_SP2
#define PG8_SP2 true
#endif
#ifndef PG8_ALIGN
#define PG8_ALIGN true
#endif
#ifndef REPM
#define REPM 0
#endif
#ifndef MK_LOCALBAR
#define MK_LOCALBAR 1
#endif
#define NREP(bit) (((REPM) & (bit)) ? 2 : 1)
struct Params { const float* in[18]; float* out; unsigned char* ws; int ph_lo, ph_hi; };
__global__ void __launch_bounds__(512, 2) mk_fwd(Params p) {
    extern __shared__ __attribute__((aligned(16))) unsigned char lds_raw[];
    Ctx C; C.lds = (LAS unsigned char*)lds_raw; C.wv = __builtin_amdgcn_readfirstlane((int)threadIdx.x >> 6); C.blk = blockIdx.x; C.nblk = gridDim.x; C.out = p.out; C.ws = p.ws;
    C.vb = (C.nblk & 7) ? C.blk : (C.blk & 7) * (C.nblk >> 3) + (C.blk >> 3);
    volatile LAS unsigned* MISC = (volatile LAS unsigned*)(C.lds + MISC_OFF);
    if (threadIdx.x < 32) MISC[threadIdx.x] = 0u;
    __syncthreads();
    const int lo = p.ph_lo, hi = p.ph_hi;
    unsigned* barw = (unsigned*)(p.ws + WS_CTL) + CW_BAR;
    XcdBarrier bar; bar.wv = C.wv; bar.bar = barw; bar.x = 0; bar.st = MISC + 8;
    if (hi - lo > 1) { bar.x = xb_xcc_id(); if (C.wv == 0 && mk_lane_id() == 0) MISC[10] = xb_add(&barw[XB_XCNT(bar.x)], 1u); }
    int ph = 0;
#define RUN (ph >= lo && ph < hi)
#define SEAM do { if (ph >= lo && ph + 1 < hi) { xcd_barrier(bar); if (REPM & 16384) xcd_barrier(bar); } ++ph; } while (0)
    const int G = (int)gridDim.x, bx = (int)blockIdx.x;
    unsigned char* ws = p.ws;
    const float* smpre = (const float*)(ws + SM_PRE); const float* smpost = (const float*)(ws + SM_POST); const float* smgb = (const float*)(ws + SM_GATEB);
    if (RUN && (PHM & 1)) { for (int rep = 0; rep < NREP(1); ++rep) phase_mod(C, p.in[I_C], p.in[I_ADAW], p.in[I_ADAB]); }
    SEAM;
    if (RUN) { if (PHM & 2) { const CvtIn I{p.in[I_UP], p.in[I_DOWN], p.in[I_MIXIN], p.in[I_MIXOUT], p.in[I_POOLW], p.in[I_QKVW], p.in[I_PRE], p.in[I_POST], p.in[I_GATEB], p.in[I_POOLS], p.in[I_CONVW], p.in[I_CONVB], p.in[I_NORMW], p.in[I_SKIP]}; for (int rep = 0; rep < NREP(2); ++rep) phase_convert(C, I); }
        if (PHM & 4) phase_resid(C, p.in[I_X], false, p.in[I_PRE], p.in[I_POST], p.in[I_GATEB], false, 0.f, 0, 0, true, 0, 0, false, EPS, (MK_I8MASK & 1) != 0); }
    SEAM;
    bool uni = false; int cg = bx;
#if MK_LOCALBAR
    if (lo == 0 && hi > 2) {
        if (C.wv == 0 && mk_lane_id() == 0) { unsigned ok = ((G & 7) == 0 && bar.x < 8u) ? 1u : 0u;
            for (unsigned j = 0; j < 16; ++j) { const unsigned c = xb_ld(&barw[XB_XCNT(j)]); if (c != (j < 8u ? (unsigned)(G >> 3) : 0u)) ok = 0u; }
            MISC[11] = ok; }
        __syncthreads();
        uni = __builtin_amdgcn_readfirstlane((int)MISC[11]) != 0;
#ifdef MK_FORCE_NONUNI
        uni = false;
#endif
        if (uni) { const int rank = __builtin_amdgcn_readfirstlane((int)MISC[10]); C.vb = (int)bar.x * (G >> 3) + rank; cg = rank * 8 + (int)bar.x; }
    }
#endif
#ifndef MK_DN_REV
#define MK_DN_REV 0
#endif
#ifndef MK_DN_AUXA
#define MK_DN_AUXA 0
#endif
#ifndef MK_DN_AUXB
#define MK_DN_AUXB 0
#endif
#ifndef MK_UP_PFB
#define MK_UP_PFB 0
#endif
#ifndef MK_UP_AUXA
#define MK_UP_AUXA 0
#endif
#ifndef MK_UP_AUXB
#define MK_UP_AUXB 0
#endif
#ifndef PG8_ALIGN_UP
#define PG8_ALIGN_UP PG8_ALIGN
#endif
#define YEPS_FFN (f8 ? EPS * (F8_SH * F8_SW) * (F8_SH * F8_SW) : EPS)
#define SEAM_L do { if (ph >= lo && ph + 1 < hi) { if (uni) { xcd_barrier_local(bar); if (REPM & 65536) xcd_barrier_local(bar); } else xcd_barrier(bar); } ++ph; } while (0)
    for (int i = 0; i < 8; ++i) {
        const int l = i >> 1, f = i & 1; const bool f8 = ((MK_F8MASK >> i) & 1) != 0, i8 = ((MK_I8MASK >> i) & 1) != 0, i8n = ((MK_I8MASK >> (i + 1)) & 1) != 0, f8n = ((MK_F8MASK >> (i + 1)) & 1) != 0;
        if (f == 1) {
            if (RUN && (PHM & 8)) {
                pg8::Gemm g{(const bf16_t*)(ws + WS_U), (const bf16_t*)(ws + WS_WIN) + (size_t)l * NIN * 1024, M, NIN, 1024}; pg8::StaticOrder S; S.init(M, NIN, G, cg);
                pg8::EpiMixIn E{(bf16_t*)(ws + WS_Q16), (bf16_t*)(ws + WS_K16), (bf16_t*)(ws + WS_VT16), (bf16_t*)(ws + WS_PIN), (bf16_t*)(ws + WS_XM), (bf16_t*)(ws + WS_OG)};
#if MK_I8IN
                const pg8::Gemm g8{(const bf16_t*)(ws + WS_U), (const bf16_t*)(ws + WS_WIN + (size_t)l * NIN * 1024 * 2), M, NIN, 512, false, U8_BSTRIDE - (size_t)4096 * 1024};
                const pg8::EpiMixInI8 E8{E, ws + WS_U, (const float*)(ws + WS_WIN + (size_t)l * NIN * 1024 * 2 + WIN_CS)};
                for (int rep = 0; rep < NREP(8); ++rep) pg8::gemm_phase<pg8::EpiMixInI8, pg8::StaticOrder, PG8_ALIGN, PG8_SP2, 3>(C.lds, g8, S, E8, C.wv); }
#else
                for (int rep = 0; rep < NREP(8); ++rep) pg8::gemm_phase<pg8::EpiMixIn, pg8::StaticOrder, PG8_ALIGN, PG8_SP2>(C.lds, g, S, E, C.wv); }
#endif
            SEAM_L;
            if (RUN) { for (int rep = 0; rep < NREP(16); ++rep) phase_attn(C); for (int rep = 0; rep < NREP(32); ++rep) phase_pool(C, l); for (int rep = 0; rep < NREP(64); ++rep) phase_mlstm_a(C, l); }
            SEAM_L;
            if (RUN && (PHM & 128)) phase_scan(C);
            SEAM_L;
            if (RUN) { for (int rep = 0; rep < NREP(256); ++rep) phase_mlstm_c(C, l); }
            SEAM_L;
            if (RUN && (PHM & 512)) {
                pg8::Gemm g{(const bf16_t*)(ws + WS_U), (const bf16_t*)(ws + WS_WOUT) + (size_t)l * 1024 * 1024, M, 1024, 1024}; pg8::StaticOrder S; S.init(M, 1024, G, cg);
                pg8::EpiY E{(bf16_t*)(ws + WS_Y), 1024};
                for (int rep = 0; rep < NREP(512); ++rep) pg8::gemm_phase<pg8::EpiY, pg8::StaticOrder, PG8_ALIGN, PG8_SP2>(C.lds, g, S, E, C.wv); }
            SEAM_L;
            if (RUN && (PHM & 1024)) { phase_resid(C, nullptr, false, smpre, smpost, smgb, true, 1.0f, l, 1, true, l, 2, false, EPS, i8); if (REPM & 8192) phase_resid(C, nullptr, false, smpre, smpost, smgb, true, 0.0f, l, 1, true, l, 2, false, EPS, i8); if (REPM & 131072) phase_resid(C, nullptr, false, smpre, smpost, smgb, false, 0.0f, l, 1, true, l, 2, false, EPS, i8); }
            SEAM;
        }
        if (RUN && (PHM & 2048)) {
            pg8::Gemm g{(const bf16_t*)(ws + WS_U), (const bf16_t*)(ws + WS_WUP) + (size_t)(l * 2 + f) * NUP * 1024, M, NUP, 1024}; pg8::StaticOrder S; S.init(M, NUP, G, cg);
            if (i8) { const pg8::Gemm g8{(const bf16_t*)(ws + WS_U), (const bf16_t*)(ws + WS_WUP + (size_t)i * WUP_SLOT), M, NUP, 512, false, U8_BSTRIDE - (size_t)4096 * 1024};
                if (f8) { const pg8::EpiSwigluI8T<true> E{ws + WS_HID, HID_PITCH8, true, ws + WS_U, (const float*)(ws + WS_WUP + (size_t)i * WUP_SLOT + WUP_CS), DFF};
                    for (int rep = 0; rep < NREP(2048); ++rep) pg8::gemm_phase<pg8::EpiSwigluI8T<true>, pg8::StaticOrder, PG8_ALIGN_UP, PG8_SP2, 3, MK_UP_AUXA, MK_UP_AUXB, MK_UP_PFB>(C.lds, g8, S, E, C.wv); }
                else { const pg8::EpiSwigluI8T<false> E{ws + WS_HID, HID_PITCH16, false, ws + WS_U, (const float*)(ws + WS_WUP + (size_t)i * WUP_SLOT + WUP_CS), DFF};
                    for (int rep = 0; rep < NREP(2048); ++rep) pg8::gemm_phase<pg8::EpiSwigluI8T<false>, pg8::StaticOrder, PG8_ALIGN_UP, PG8_SP2, 3, MK_UP_AUXA, MK_UP_AUXB, MK_UP_PFB>(C.lds, g8, S, E, C.wv); }
            } else { pg8::EpiSwigluX E{ws + WS_HID, f8 ? HID_PITCH8 : HID_PITCH16, f8};
                for (int rep = 0; rep < NREP(2048); ++rep) pg8::gemm_phase<pg8::EpiSwigluX, pg8::StaticOrder, PG8_ALIGN_UP, PG8_SP2>(C.lds, g, S, E, C.wv); } }
        SEAM_L;
        if (RUN && (PHM & 4096)) {
            pg8::Gemm g{(const bf16_t*)(ws + WS_HID), (const bf16_t*)(ws + WS_WDN) + (size_t)(l * 2 + f) * 1024 * DFF, M, 1024, f8 ? DFF / 2 : DFF, f8, 0, f8 ? HID_PITCH8 / 2 : HID_PITCH16}; pg8::StaticOrder S; S.init(M, 1024, G, cg); S.rev = MK_DN_REV;
            pg8::EpiY E{(bf16_t*)(ws + WS_Y), 1024};
            for (int rep = 0; rep < NREP(4096); ++rep) { if (f8) pg8::gemm_phase<pg8::EpiY, pg8::StaticOrder, PG8_ALIGN, PG8_SP2, 1, MK_DN_AUXA, MK_DN_AUXB>(C.lds, g, S, E, C.wv); else pg8::gemm_phase<pg8::EpiY, pg8::StaticOrder, PG8_ALIGN, PG8_SP2, 0, MK_DN_AUXA, MK_DN_AUXB>(C.lds, g, S, E, C.wv); } }
        SEAM_L;
        if (RUN && (PHM & 8192)) { const bool has_next = (i < 7); const int ln = f == 0 ? l : l + 1, sn = f == 0 ? 1 : 0;
            phase_resid(C, i == 0 ? p.in[I_X] : (const float*)nullptr, !has_next, smpre, smpost, smgb, true, 0.5f, l, f == 0 ? 0 : 2, has_next, has_next ? ln : 0, sn, f == 0, YEPS_FFN, f == 1 ? (has_next && i8n) : (MK_I8IN != 0)); if ((REPM & 8192) && has_next) phase_resid(C, nullptr, false, smpre, smpost, smgb, true, 0.0f, l, f == 0 ? 0 : 2, has_next, ln, sn, f == 0, YEPS_FFN, f == 1 ? i8n : (MK_I8IN != 0)); if ((REPM & 131072) && has_next) phase_resid(C, nullptr, false, smpre, smpost, smgb, false, 0.0f, l, f == 0 ? 0 : 2, has_next, ln, sn, f == 0, YEPS_FFN, f == 1 ? i8n : (MK_I8IN != 0)); if ((REPM & 262144) && has_next && f == 0) phase_resid(C, nullptr, false, smpre, smpost, smgb, true, 0.0f, l, f == 0 ? 0 : 2, has_next, ln, sn, f == 0, YEPS_FFN, f == 1 ? i8n : (MK_I8IN != 0)); if ((REPM & 131072) && has_next) phase_resid(C, nullptr, false, smpre, smpost, smgb, false, 0.0f, l, f == 0 ? 0 : 2, has_next, ln, sn, f == 0, YEPS_FFN, f == 1 ? i8n : (MK_I8IN != 0)); }
        if (f == 0 || f8 != f8n) SEAM; else SEAM_L;
    }
#undef RUN
#undef SEAM
#undef SEAM_L
}

#ifndef MK_MULTI
#define MK_MULTI 0
#endif
extern "C" void kernel_launch(void* const* d_in, const int* in_sizes, int n_in, void* d_out, int out_size, void* d_ws, size_t ws_size, hipStream_t stream) {
    static int grid = 0;
    if (grid == 0) {
        if (n_in != 18 || in_sizes[0] != M * DM || out_size != M * DM || ws_size < WS_END) { fprintf(stderr, "kernel_launch: unexpected shapes (n_in %d, in0 %d, out %d, ws %zu < %zu); nothing launched\n", n_in, n_in > 0 ? in_sizes[0] : -1, out_size, ws_size, (size_t)WS_END); grid = -1; return; }
        int dev = 0, cus = 0, per_cu = 0;
        if (hipGetDevice(&dev) != hipSuccess || hipDeviceGetAttribute(&cus, hipDeviceAttributeMultiprocessorCount, dev) != hipSuccess) { grid = -1; return; }
        if (hipFuncSetAttribute((const void*)mk_fwd, hipFuncAttributeMaxDynamicSharedMemorySize, LDS_BYTES) != hipSuccess) { fprintf(stderr, "kernel_launch: hipFuncSetAttribute failed\n"); grid = -1; return; }
        if (hipOccupancyMaxActiveBlocksPerMultiprocessor(&per_cu, (const void*)mk_fwd, 512, LDS_BYTES) != hipSuccess || per_cu < 1) { fprintf(stderr, "kernel_launch: occupancy query reports %d workgroups per CU\n", per_cu); }
        (void)hipGetLastError();
        grid = cus;
    }
    if (grid < 0) return;
    if (hipMemsetAsync((char*)d_ws + WS_CTL, 0, CTL_ZERO_BYTES, stream) != hipSuccess) return;
    Params p{};
    for (int i = 0; i < 18; ++i) p.in[i] = (const float*)d_in[i];
    p.out = (float*)d_out; p.ws = (unsigned char*)d_ws;
#if MK_MULTI
#ifndef MK_MAXPH
#define MK_MAXPH N_PHASES
#endif
    for (int k = 0; k < MK_MAXPH; ++k) { p.ph_lo = k; p.ph_hi = k + 1; hipLaunchKernelGGL(mk_fwd, dim3(grid), dim3(512), LDS_BYTES, stream, p); }
#else
    p.ph_lo = 0; p.ph_hi = N_PHASES;
    hipLaunchKernelGGL(mk_fwd, dim3(grid), dim3(512), LDS_BYTES, stream, p);
#endif
}
#endif
```
